# Optimizing an MI355X kernel written in HIP

```python
import math
import jax, jax.numpy as jnp
from jax import lax
import numpy as np

D_MODEL = 1024
BATCH = 8
SEQ = 4096
DEPTH = 4

HEAD_DIM = 64
N_FOX_HEADS = 8
N_SB_HEADS = 8
N_MOBA_HEADS = 8
N_MLA_HEADS = 8
Q_BLOCK = 128
MOBA_BLOCK = 256
MOBA_TOPK = 3
MOBA_Q_CHUNK = 32
MLA_Q_LORA = 256
MLA_KV_LORA = 128
MLA_NOPE_DIM = 64
MLA_ROPE_DIM = 32
MLA_V_DIM = 64
MLA_QK_DIM = MLA_NOPE_DIM + MLA_ROPE_DIM
ROPE_BASE = 10000.0
REL_BUCKETS = 32
REL_MAX_EXACT = 16
REL_MAX_DISTANCE = 128
D_FF = ((8 * D_MODEL + 3 * 256 - 1) // (3 * 256)) * 256
RMS_EPS = 1e-6
N_EVEN = (DEPTH + 1) // 2
N_ODD = DEPTH // 2
FOX_W = N_FOX_HEADS * HEAD_DIM
SB_W = N_SB_HEADS * HEAD_DIM
MOBA_W = N_MOBA_HEADS * HEAD_DIM
EVEN_WIDTHS = (FOX_W, FOX_W, FOX_W, N_FOX_HEADS, SB_W, SB_W, SB_W)
ODD_WIDTHS = (MOBA_W, MOBA_W, MOBA_W, MLA_Q_LORA, MLA_KV_LORA, MLA_ROPE_DIM)
EVEN_IN = sum(EVEN_WIDTHS)
ODD_IN = sum(ODD_WIDTHS)
EVEN_MIX = FOX_W + SB_W
ODD_MIX = MOBA_W + N_MLA_HEADS * MLA_V_DIM

kernel_name = "hybrid_fox_stickbreak_moba_mla_trunk"


def _rms_norm(t, gain):
    tf = t.astype(jnp.float32)
    tf = tf * lax.rsqrt(jnp.mean(tf * tf, axis=-1, keepdims=True) + RMS_EPS)
    return (tf * gain.astype(jnp.float32)).astype(t.dtype)


def _split(t, widths):
    cuts = [int(c) for c in np.cumsum(widths)[:-1]]
    return jnp.split(t, cuts, axis=-1)


def _split_heads(t, n_heads):
    b, s, _ = t.shape
    return t.reshape(b, s, n_heads, -1).transpose(0, 2, 1, 3)


def _merge_heads(t):
    b, h, s, d = t.shape
    return t.transpose(0, 2, 1, 3).reshape(b, s, h * d)


def _to_blocks(t, blk):
    b, h, s = t.shape[:3]
    t = t.reshape((b, h, s // blk, blk) + t.shape[3:])
    return jnp.moveaxis(t, 2, 0)


def _from_blocks(o):
    nb, b, h, blk, d = o.shape
    return jnp.moveaxis(o, 0, 2).reshape(b, h, nb * blk, d)


def _causal_softmax_attention(q, k, v, log_decay=None):
    s_len = q.shape[2]
    scale = q.shape[-1] ** -0.5
    kpos = jnp.arange(s_len, dtype=jnp.int32)
    starts = jnp.arange(s_len // Q_BLOCK, dtype=jnp.int32) * Q_BLOCK
    xs = (_to_blocks(q, Q_BLOCK), starts)
    if log_decay is not None:
        xs = xs + (_to_blocks(log_decay, Q_BLOCK),)

    def step(args):
        qb, start = args[0], args[1]
        logits = jnp.einsum("bhqd,bhkd->bhqk", qb, k).astype(jnp.float32) * scale
        if log_decay is not None:
            logits = logits + args[2][..., None] - log_decay[:, :, None, :]
        qpos = start + jnp.arange(Q_BLOCK, dtype=jnp.int32)
        causal = kpos[None, :] <= qpos[:, None]
        p = jax.nn.softmax(jnp.where(causal, logits, -jnp.inf), axis=-1)
        return jnp.einsum("bhqk,bhkd->bhqd", p.astype(v.dtype), v)

    return _from_blocks(lax.map(step, xs))


def _stick_breaking_attention(q, k, v):
    s_len = q.shape[2]
    scale = q.shape[-1] ** -0.5
    kpos = jnp.arange(s_len, dtype=jnp.int32)
    starts = jnp.arange(s_len // Q_BLOCK, dtype=jnp.int32) * Q_BLOCK

    def step(args):
        qb, start = args
        z = jnp.einsum("bhqd,bhkd->bhqk", qb, k).astype(jnp.float32) * scale
        qpos = start + jnp.arange(Q_BLOCK, dtype=jnp.int32)
        strict = kpos[None, :] < qpos[:, None]
        log_1m = jnp.where(strict, jax.nn.log_sigmoid(-z), 0.0)
        between = lax.cumsum(log_1m, axis=3, reverse=True) - log_1m
        log_w = jnp.where(strict, jax.nn.log_sigmoid(z) + between, -jnp.inf)
        return jnp.einsum("bhqk,bhkd->bhqd", jnp.exp(log_w).astype(v.dtype), v)

    return _from_blocks(lax.map(step, (_to_blocks(q, Q_BLOCK), starts)))


def _t5_bucket(rel):
    n = jnp.maximum(rel, 0)
    nf = jnp.maximum(n, 1).astype(jnp.float32)
    large = REL_MAX_EXACT + (jnp.log(nf / REL_MAX_EXACT)
                             / math.log(REL_MAX_DISTANCE / REL_MAX_EXACT)
                             * (REL_BUCKETS - REL_MAX_EXACT)).astype(jnp.int32)
    large = jnp.minimum(large, REL_BUCKETS - 1)
    return jnp.where(n < REL_MAX_EXACT, n, large)


def _moba_attention(q, k, v, rel_bias):
    b, h, s_len, d = q.shape
    scale = d ** -0.5
    s_pad = -(-s_len // MOBA_BLOCK) * MOBA_BLOCK
    pad = ((0, 0), (0, 0), (0, s_pad - s_len), (0, 0))
    q, k, v = (jnp.pad(t, pad) for t in (q, k, v))
    n_kb = s_pad // MOBA_BLOCK
    top = min(MOBA_TOPK, n_kb)
    kb = k.reshape(b, h, n_kb, MOBA_BLOCK, d)
    vb = v.reshape(b, h, n_kb, MOBA_BLOCK, d)
    k_mean = jnp.mean(kb.astype(jnp.float32), axis=3).astype(q.dtype)
    bi = jnp.arange(b)[:, None, None, None]
    hi = jnp.arange(h)[None, :, None, None]
    offs = jnp.arange(MOBA_BLOCK, dtype=jnp.int32)
    blk_ids = jnp.arange(n_kb, dtype=jnp.int32)
    starts = jnp.arange(s_pad // MOBA_Q_CHUNK, dtype=jnp.int32) * MOBA_Q_CHUNK
    n_sel = top * MOBA_BLOCK

    def step(args):
        qc, start = args
        cur = start // MOBA_BLOCK
        qpos = start + jnp.arange(MOBA_Q_CHUNK, dtype=jnp.int32)
        gate = jnp.einsum("bhqd,bhnd->bhqn", qc, k_mean).astype(jnp.float32)
        gate = jnp.where(blk_ids < cur, gate, -jnp.inf)
        _, sel = lax.top_k(gate, top)
        valid = sel < cur
        k_sel = kb[bi, hi, sel]
        v_sel = vb[bi, hi, sel]
        kpos_sel = sel[..., None] * MOBA_BLOCK + offs
        bias_sel = rel_bias[hi[..., None], _t5_bucket(qpos[:, None, None] - kpos_sel)]
        s_sel = (jnp.einsum("bhqd,bhqrkd->bhqrk", qc, k_sel).astype(jnp.float32) * scale
                 + bias_sel.astype(jnp.float32))
        s_sel = jnp.where(valid[..., None], s_sel, -jnp.inf)
        k_own = lax.dynamic_index_in_dim(kb, cur, axis=2, keepdims=False)
        v_own = lax.dynamic_index_in_dim(vb, cur, axis=2, keepdims=False)
        kpos_own = cur * MOBA_BLOCK + offs
        bias_own = rel_bias[:, _t5_bucket(qpos[:, None] - kpos_own[None, :])]
        s_own = (jnp.einsum("bhqd,bhkd->bhqk", qc, k_own).astype(jnp.float32) * scale
                 + bias_own.astype(jnp.float32))
        s_own = jnp.where(kpos_own[None, :] <= qpos[:, None], s_own, -jnp.inf)
        logits = jnp.concatenate([s_sel.reshape(b, h, MOBA_Q_CHUNK, n_sel), s_own], axis=-1)
        p = jax.nn.softmax(logits, axis=-1).astype(v.dtype)
        p_sel = p[..., :n_sel].reshape(b, h, MOBA_Q_CHUNK, top, MOBA_BLOCK)
        p_own = p[..., n_sel:]
        return (jnp.einsum("bhqrk,bhqrkd->bhqd", p_sel, v_sel)
                + jnp.einsum("bhqk,bhkd->bhqd", p_own, v_own))

    out = _from_blocks(lax.map(step, (_to_blocks(q, MOBA_Q_CHUNK), starts)))
    return out[:, :, :s_len]


def _rope_tail(t):
    s_len = t.shape[2]
    half = MLA_ROPE_DIM // 2
    inv_freq = ROPE_BASE ** (-jnp.arange(half, dtype=jnp.float32) / half)
    ang = jnp.arange(s_len, dtype=jnp.float32)[:, None] * inv_freq[None, :]
    cos, sin = jnp.cos(ang), jnp.sin(ang)
    nope, x1, x2 = _split(t, (MLA_NOPE_DIM, half, half))
    x1f, x2f = x1.astype(jnp.float32), x2.astype(jnp.float32)
    rot = jnp.concatenate([x1f * cos - x2f * sin, x1f * sin + x2f * cos], axis=-1)
    return jnp.concatenate([nope, rot.astype(t.dtype)], axis=-1)


def _even_mixer(h, w_in, forget_bias, fox_q_norm, fox_k_norm):
    qa, ka, va, fa, qb, kb, vb = _split(h @ w_in, EVEN_WIDTHS)
    qa = _rms_norm(_split_heads(qa, N_FOX_HEADS), fox_q_norm)
    ka = _rms_norm(_split_heads(ka, N_FOX_HEADS), fox_k_norm)
    log_f = jax.nn.log_sigmoid(fa.astype(jnp.float32) + forget_bias.astype(jnp.float32))
    log_decay = lax.cumsum(log_f.transpose(0, 2, 1), axis=2)
    out_a = _causal_softmax_attention(qa, ka, _split_heads(va, N_FOX_HEADS), log_decay)
    out_b = _stick_breaking_attention(_split_heads(qb, N_SB_HEADS), _split_heads(kb, N_SB_HEADS),
                                      _split_heads(vb, N_SB_HEADS))
    return jnp.concatenate([_merge_heads(out_a), _merge_heads(out_b)], axis=-1)


def _odd_mixer(h, w_in, moba_q_norm, moba_k_norm, q_a_norm, w_q_b, kv_a_norm, w_kv_b,
               mla_q_norm, mla_k_norm, rel_bias):
    qc, kc, vc, q_lat, kv_lat, k_rope = _split(h @ w_in, ODD_WIDTHS)
    qc = _rms_norm(_split_heads(qc, N_MOBA_HEADS), moba_q_norm)
    kc = _rms_norm(_split_heads(kc, N_MOBA_HEADS), moba_k_norm)
    out_c = _moba_attention(qc, kc, _split_heads(vc, N_MOBA_HEADS), rel_bias)
    qd = _split_heads(_rms_norm(q_lat, q_a_norm) @ w_q_b, N_MLA_HEADS)
    kvd = _split_heads(_rms_norm(kv_lat, kv_a_norm) @ w_kv_b, N_MLA_HEADS)
    k_nope, vd = _split(kvd, (MLA_NOPE_DIM, MLA_V_DIM))
    b, _, s_len, _ = k_nope.shape
    k_r = jnp.broadcast_to(k_rope[:, None], (b, N_MLA_HEADS, s_len, MLA_ROPE_DIM))
    kd = jnp.concatenate([k_nope, k_r], axis=-1)
    qd = _rope_tail(_rms_norm(qd, mla_q_norm))
    kd = _rope_tail(_rms_norm(kd, mla_k_norm))
    out_d = _causal_softmax_attention(qd, kd, vd)
    return jnp.concatenate([_merge_heads(out_c), _merge_heads(out_d)], axis=-1)


def _swiglu(h, w_gate_up, w_down):
    g, u = jnp.split(h @ w_gate_up, 2, axis=-1)
    return (jax.nn.silu(g) * u) @ w_down


def setup_inputs(seed: int = 0) -> dict:
    key = jax.random.key(seed)
    ks = jax.random.split(key, 22)

    def nrm(k, shape, scale):
        return scale * jax.random.normal(k, shape, jnp.float32)

    def gain(k, shape):
        return 1.0 + 0.02 * jax.random.normal(k, shape, jnp.float32)

    return {
        "x": jax.random.normal(ks[0], (BATCH, SEQ, D_MODEL), jnp.float32),
        "ffn_norm": gain(ks[1], (DEPTH, D_MODEL)),
        "ffn_w_gate_up": nrm(ks[2], (DEPTH, D_MODEL, 2 * D_FF), D_MODEL ** -0.5),
        "ffn_w_down": nrm(ks[3], (DEPTH, D_FF, D_MODEL), D_FF ** -0.5),
        "rel_bias": nrm(ks[4], (N_MOBA_HEADS, REL_BUCKETS), 0.5),
        "ev_norm": gain(ks[5], (N_EVEN, D_MODEL)),
        "ev_w_in": nrm(ks[6], (N_EVEN, D_MODEL, EVEN_IN), D_MODEL ** -0.5),
        "ev_forget_bias": jax.random.uniform(ks[7], (N_EVEN, N_FOX_HEADS), jnp.float32, 1.0, 4.0),
        "ev_fox_q_norm": gain(ks[8], (N_EVEN, HEAD_DIM)),
        "ev_fox_k_norm": gain(ks[9], (N_EVEN, HEAD_DIM)),
        "ev_w_out": nrm(ks[10], (N_EVEN, EVEN_MIX, D_MODEL), EVEN_MIX ** -0.5),
        "od_norm": gain(ks[11], (N_ODD, D_MODEL)),
        "od_w_in": nrm(ks[12], (N_ODD, D_MODEL, ODD_IN), D_MODEL ** -0.5),
        "od_moba_q_norm": gain(ks[13], (N_ODD, HEAD_DIM)),
        "od_moba_k_norm": gain(ks[14], (N_ODD, HEAD_DIM)),
        "od_mla_q_a_norm": gain(ks[15], (N_ODD, MLA_Q_LORA)),
        "od_mla_w_q_b": nrm(ks[16], (N_ODD, MLA_Q_LORA, N_MLA_HEADS * MLA_QK_DIM), MLA_Q_LORA ** -0.5),
        "od_mla_kv_a_norm": gain(ks[17], (N_ODD, MLA_KV_LORA)),
        "od_mla_w_kv_b": nrm(ks[18], (N_ODD, MLA_KV_LORA, N_MLA_HEADS * (MLA_NOPE_DIM + MLA_V_DIM)),
                             MLA_KV_LORA ** -0.5),
        "od_mla_q_norm": gain(ks[19], (N_ODD, MLA_QK_DIM)),
        "od_mla_k_norm": gain(ks[20], (N_ODD, MLA_QK_DIM)),
        "od_w_out": nrm(ks[21], (N_ODD, ODD_MIX, D_MODEL), ODD_MIX ** -0.5),
    }


def reference(x, ffn_norm, ffn_w_gate_up, ffn_w_down, rel_bias, ev_norm, ev_w_in,
              ev_forget_bias, ev_fox_q_norm, ev_fox_k_norm, ev_w_out, od_norm, od_w_in,
              od_moba_q_norm, od_moba_k_norm, od_mla_q_a_norm, od_mla_w_q_b,
              od_mla_kv_a_norm, od_mla_w_kv_b, od_mla_q_norm, od_mla_k_norm, od_w_out):
    for layer in range(DEPTH):
        i = layer // 2
        if layer % 2 == 0:
            h = _rms_norm(x, ev_norm[i])
            mixed = _even_mixer(h, ev_w_in[i], ev_forget_bias[i], ev_fox_q_norm[i], ev_fox_k_norm[i])
            x = x + mixed @ ev_w_out[i]
        else:
            h = _rms_norm(x, od_norm[i])
            mixed = _odd_mixer(h, od_w_in[i], od_moba_q_norm[i], od_moba_k_norm[i],
                               od_mla_q_a_norm[i], od_mla_w_q_b[i], od_mla_kv_a_norm[i],
                               od_mla_w_kv_b[i], od_mla_q_norm[i], od_mla_k_norm[i], rel_bias)
            x = x + mixed @ od_w_out[i]
        h = _rms_norm(x, ffn_norm[layer])
        x = x + _swiglu(h, ffn_w_gate_up[layer], ffn_w_down[layer])
    return x
```

```cpp
#include <hip/hip_runtime.h>
#include <hip/hip_cooperative_groups.h>
#include <cstdio>
#include <cstdint>
namespace cg = cooperative_groups;

typedef unsigned short bf16_t;
typedef short bf16x8 __attribute__((ext_vector_type(8)));
typedef float f32x4 __attribute__((ext_vector_type(4)));
typedef unsigned u32x4 __attribute__((ext_vector_type(4)));
typedef unsigned u32x2 __attribute__((ext_vector_type(2)));

#define DEV __device__ __forceinline__
#define NO_SB_EXIT 0
#define DBG_SKIP_SB 0
#define DBG_NOSHFL 0
#define DBG_SKIP_FOX 0
#define DBG_OFF1 OFF_EB
#define DBG_OFF2 OFF_VT

constexpr int M_TOK = 32768, SEQ = 4096, DM = 1024, DFF = 2816;
constexpr float EPS = 1e-6f;
constexpr float LOG2E = 1.4426950408889634f;

constexpr size_t SZ_EVIN = 3200ull * 1024, SZ_ODIN = 2048ull * 1024, SZ_OUT = 1024ull * 1024, SZ_GU = 5632ull * 1024,
                 SZ_DN = 1024ull * 2816, SZ_QB = 768ull * 256, SZ_KVB = 1024ull * 128;
constexpr size_t OFF_EVIN = 0;
constexpr size_t OFF_ODIN = OFF_EVIN + 2 * SZ_EVIN * 2;
constexpr size_t OFF_EVOUT = OFF_ODIN + 2 * SZ_ODIN * 2;
constexpr size_t OFF_ODOUT = OFF_EVOUT + 2 * SZ_OUT * 2;
constexpr size_t OFF_GU = OFF_ODOUT + 2 * SZ_OUT * 2;
constexpr size_t OFF_DN = OFF_GU + 4 * SZ_GU * 2;
constexpr size_t OFF_QB = OFF_DN + 4 * SZ_DN * 2;
constexpr size_t OFF_KVB = OFF_QB + 2 * SZ_QB * 2;
constexpr size_t OFF_HM = OFF_KVB + 2 * SZ_KVB * 2;
constexpr size_t OFF_EB = OFF_HM + (size_t)M_TOK * 1024 * 2;
constexpr size_t OFF_VT = OFF_EB + (size_t)M_TOK * 2048 * 2;
constexpr size_t OFF_QD = OFF_VT + (size_t)M_TOK * 1024 * 2;
constexpr size_t OFF_KD = OFF_QD + (size_t)M_TOK * 768 * 2;
constexpr size_t OFF_FA = OFF_KD + (size_t)M_TOK * 768 * 2;
constexpr size_t OFF_CDEC = OFF_FA + (size_t)M_TOK * 8 * 4;
constexpr size_t OFF_KMEAN = OFF_CDEC + 64ull * 4096 * 4;
constexpr size_t OFF_SEL = OFF_KMEAN + 8ull * 8 * 16 * 64 * 4;
constexpr size_t OFF_BTAB = OFF_SEL + 64ull * 4096 * 4;
constexpr size_t OFF_ROPE = OFF_BTAB + 8ull * 128 * 4;
constexpr size_t OFF_END = OFF_ROPE + 2ull * 4096 * 16 * 4;
constexpr size_t OFF_BAR = OFF_END;
constexpr size_t OFF_ACT = OFF_EB;
static_assert((size_t)M_TOK * DFF * 2 <= (size_t)M_TOK * 3072 * 2, "ACT overlay");

constexpr int SMEM_BYTES = 73728;

struct Params {
    const float* x; const float* ffn_norm; const float* w_gu; const float* w_dn; const float* rel_bias;
    const float* ev_norm; const float* ev_w_in; const float* ev_fb; const float* ev_qn; const float* ev_kn; const float* ev_w_out;
    const float* od_norm; const float* od_w_in; const float* od_mqn; const float* od_mkn; const float* od_qan; const float* od_wqb;
    const float* od_kvan; const float* od_wkvb; const float* od_lqn; const float* od_lkn; const float* od_w_out;
    float* out; char* ws;
};

typedef __bf16 bf16v2_t __attribute__((ext_vector_type(2)));
typedef float f32x2_t __attribute__((ext_vector_type(2)));
DEV unsigned pk_bf16(float lo, float hi) { f32x2_t v = {lo, hi}; bf16v2_t b = __builtin_convertvector(v, bf16v2_t); return __builtin_bit_cast(unsigned, b); }
DEV int opq_v(int x) { asm volatile("" : "+v"(x)); return x; }
DEV int opq_s(int x) { asm volatile("" : "+s"(x)); return x; }
#define TID opq_v((int)threadIdx.x)
#define BID opq_s((int)blockIdx.x)
DEV float bf_lo(unsigned u) { return __uint_as_float(u << 16); }
DEV float bf_hi(unsigned u) { return __uint_as_float(u & 0xffff0000u); }

enum { WM_ID = 0, WM_EVIN, WM_ODIN, WM_GU, WM_KVB };
DEV int srcmap(int mode, int n) {
    switch (mode) {
    case WM_EVIN:
        if (n < 1024) return n;
        if (n < 1536) return 1544 + (n - 1024);
        if (n < 2048) return 2056 + (n - 1536);
        if (n < 2560) return 1024 + (n - 2048);
        if (n < 3072) return 2568 + (n - 2560);
        if (n < 3080) return 1536 + (n - 3072);
        return -1;
    case WM_ODIN:
        if (n < 1024) return n;
        if (n < 1280) return 1536 + (n - 1024);
        if (n < 1408) return 1792 + (n - 1280);
        if (n < 1440) return 1920 + (n - 1408);
        if (n < 1536) return -1;
        return 1024 + (n - 1536);
    case WM_GU: { int i = n >> 5, t = n & 31; return t < 16 ? 16 * i + t : 2816 + 16 * i + (t - 16); }
    case WM_KVB: { if (n < 512) return (n >> 6) * 128 + (n & 63); int m = n - 512; return (m >> 6) * 128 + 64 + (m & 63); }
    default: return n;
    }
}

DEV void convert_matrix(const float* __restrict__ W, bf16_t* __restrict__ Bt, int K, int N, int Np, int mode, float* lds) {
    const int tid = TID;
    const int nkt = K >> 6, ntiles = (Np >> 6) * nkt;
    for (int t = BID; t < ntiles; t += gridDim.x) {
        const int k0 = (t % nkt) << 6, n0 = (t / nkt) << 6;
        const int nn = tid & 63, src = srcmap(mode, n0 + nn);
        __syncthreads();
#pragma unroll 4
        for (int i = 0; i < 16; ++i) {
            const int kk = (tid >> 6) + 4 * i;
            lds[nn * 65 + kk] = src >= 0 ? W[(size_t)(k0 + kk) * N + src] : 0.f;
        }
        __syncthreads();
        const int r = tid >> 2, c = tid & 3;
        const float* lp = lds + r * 65 + c * 16;
        u32x4 a, b;
        a.x = pk_bf16(lp[0], lp[1]); a.y = pk_bf16(lp[2], lp[3]); a.z = pk_bf16(lp[4], lp[5]); a.w = pk_bf16(lp[6], lp[7]);
        b.x = pk_bf16(lp[8], lp[9]); b.y = pk_bf16(lp[10], lp[11]); b.z = pk_bf16(lp[12], lp[13]); b.w = pk_bf16(lp[14], lp[15]);
        bf16_t* dp = Bt + (size_t)(n0 + r) * K + k0 + c * 16;
        *(u32x4*)dp = a; *(u32x4*)(dp + 8) = b;
    }
}

DEV void prologue(const Params& p, char* smem) {
    float* lds = (float*)smem;
    char* ws = p.ws;
    for (int i = 0; i < 2; ++i) {
        convert_matrix(p.ev_w_in + (size_t)i * 1024 * 3080, (bf16_t*)(ws + OFF_EVIN) + i * SZ_EVIN, 1024, 3080, 3200, WM_EVIN, lds);
        convert_matrix(p.od_w_in + (size_t)i * 1024 * 1952, (bf16_t*)(ws + OFF_ODIN) + i * SZ_ODIN, 1024, 1952, 2048, WM_ODIN, lds);
        convert_matrix(p.ev_w_out + (size_t)i * 1024 * 1024, (bf16_t*)(ws + OFF_EVOUT) + i * SZ_OUT, 1024, 1024, 1024, WM_ID, lds);
        convert_matrix(p.od_w_out + (size_t)i * 1024 * 1024, (bf16_t*)(ws + OFF_ODOUT) + i * SZ_OUT, 1024, 1024, 1024, WM_ID, lds);
        convert_matrix(p.od_wqb + (size_t)i * 256 * 768, (bf16_t*)(ws + OFF_QB) + i * SZ_QB, 256, 768, 768, WM_ID, lds);
        convert_matrix(p.od_wkvb + (size_t)i * 128 * 1024, (bf16_t*)(ws + OFF_KVB) + i * SZ_KVB, 128, 1024, 1024, WM_KVB, lds);
    }
    for (int l = 0; l < 4; ++l) {
        convert_matrix(p.w_gu + (size_t)l * 1024 * 5632, (bf16_t*)(ws + OFF_GU) + l * SZ_GU, 1024, 5632, 5632, WM_GU, lds);
        convert_matrix(p.w_dn + (size_t)l * 2816 * 1024, (bf16_t*)(ws + OFF_DN) + l * SZ_DN, 2816, 1024, 1024, WM_ID, lds);
    }
    const int gt = BID * blockDim.x + TID, gn = gridDim.x * blockDim.x;
    float* btab = (float*)(ws + OFF_BTAB);
    for (int i = gt; i < 8 * 128; i += gn) {
        const int h = i >> 7, n = i & 127;
        int bucket;
        if (n < 16) bucket = n;
        else { const float v = logf((float)n / 16.0f) / 2.0794415416798357f * 16.0f; bucket = 16 + (int)v; if (bucket > 31) bucket = 31; }
        btab[i] = p.rel_bias[h * 32 + bucket] * LOG2E;
    }
    float* rope = (float*)(ws + OFF_ROPE);
    for (int i = gt; i < 4096 * 16; i += gn) {
        const int pos = i >> 4, f = i & 15;
        const float inv = powf(10000.0f, -(float)f / 16.0f);
        const float ang = (float)pos * inv;
        const double a = (double)ang;
        const double r = a - 6.283185307179586476925 * rint(a * 0.15915494309189533577);
        const float fr_ = (float)(r * 0.15915494309189533577);
        rope[i] = __builtin_amdgcn_cosf(fr_);
        rope[4096 * 16 + i] = __builtin_amdgcn_sinf(fr_);
    }
}

DEV void norm_phase(const float* __restrict__ x, const float* __restrict__ gain, bf16_t* __restrict__ h) {
    const int lane = TID & 63, wv = (BID * blockDim.x + TID) >> 6, nw = (gridDim.x * blockDim.x) >> 6;
    f32x4 g[4];
#pragma unroll
    for (int i = 0; i < 4; ++i) g[i] = *(const f32x4*)(gain + 4 * (lane + 64 * i));
    for (int row = wv; row < M_TOK; row += nw) {
        const float* xr = x + (size_t)row * DM;
        f32x4 v[4]; float ss = 0.f;
#pragma unroll
        for (int i = 0; i < 4; ++i) { v[i] = *(const f32x4*)(xr + 4 * (lane + 64 * i)); ss += v[i][0] * v[i][0] + v[i][1] * v[i][1] + v[i][2] * v[i][2] + v[i][3] * v[i][3]; }
#pragma unroll
        for (int o = 32; o > 0; o >>= 1) ss += __shfl_xor(ss, o);
        const float rstd = rsqrtf(ss * (1.0f / DM) + EPS);
        bf16_t* hr = h + (size_t)row * DM;
#pragma unroll
        for (int i = 0; i < 4; ++i) {
            u32x2 o; o.x = pk_bf16(v[i][0] * rstd * g[i][0], v[i][1] * rstd * g[i][1]); o.y = pk_bf16(v[i][2] * rstd * g[i][2], v[i][3] * rstd * g[i][3]);
            *(u32x2*)(hr + 4 * (lane + 64 * i)) = o;
        }
    }
}

enum { EPI_EVIN = 0, EPI_ODIN, EPI_QB, EPI_KVB, EPI_RESID, EPI_SWIGLU };
struct GemmP {
    const bf16_t* A; int lda; const bf16_t* Bt; int K; int nN; int epi;
    const float* xin; float* xout;
};

DEV void gemm_phase(const GemmP& g, char* smem, char* ws) {
    const int tid = TID, wid = tid >> 6, lane = tid & 63, fr = lane & 15, fq = lane >> 4;
    const int wp = wid >> 1, wq = wid & 1;
    const int nbx = gridDim.x >> 3, xcd = BID & 7, lb = BID >> 3;
    const int per_xcd = 32 * g.nN, grpsz = 8 * g.nN;
    const int K = g.K, lda = g.lda, nkt = K >> 6;
    const int lrow = tid >> 3, lchk = tid & 7;
    for (int t = lb; t < per_xcd; t += nbx) {
        const int grp = t / grpsz, r = t - grp * grpsz;
        const int tm = xcd * 32 + grp * 8 + (r & 7), tn = r >> 3;
        bool vt_tile = false; int vt_head = 0;
        if (g.epi == EPI_EVIN) { if (tn >= 16 && tn < 24) { vt_tile = true; vt_head = (tn - 16) * 2; } }
        else if (g.epi == EPI_ODIN) { if (tn >= 12) { vt_tile = true; vt_head = (tn - 12) * 2; } }
        else if (g.epi == EPI_KVB) { if (tn >= 4) { vt_tile = true; vt_head = 8 + (tn - 4) * 2; } }
        const bf16_t* Ag = g.A + (size_t)(tm * 128 + lrow) * lda + lchk * 8;
        const bf16_t* Wg = g.Bt + (size_t)(tn * 128 + lrow) * K + lchk * 8;
        u32x4 ra[4], rw[4];
        f32x4 acc[4][4];
#pragma unroll
        for (int i = 0; i < 4; ++i)
#pragma unroll
            for (int j = 0; j < 4; ++j) acc[i][j] = (f32x4){0.f, 0.f, 0.f, 0.f};
#pragma unroll
        for (int i = 0; i < 4; ++i) { ra[i] = *(const u32x4*)(Ag + (size_t)i * 32 * lda); rw[i] = *(const u32x4*)(Wg + (size_t)i * 32 * K); }
        __syncthreads();
#pragma unroll
        for (int i = 0; i < 4; ++i) {
            *(u32x4*)(smem + (lrow + 32 * i) * 144 + lchk * 16) = ra[i];
            *(u32x4*)(smem + 18432 + (lrow + 32 * i) * 144 + lchk * 16) = rw[i];
        }
        __syncthreads();
        for (int kt = 0; kt < nkt; ++kt) {
            const int buf = kt & 1;
            const bool more = kt + 1 < nkt;
            if (more) {
                const int k0 = (kt + 1) << 6;
#pragma unroll
                for (int i = 0; i < 4; ++i) { ra[i] = *(const u32x4*)(Ag + (size_t)i * 32 * lda + k0); rw[i] = *(const u32x4*)(Wg + (size_t)i * 32 * K + k0); }
            }
            const char* sX = smem + buf * 36864;
            const char* sW = sX + 18432;
            const char* pP = vt_tile ? sX : sW;
            const char* pQ = vt_tile ? sW : sX;
#pragma unroll
            for (int ks = 0; ks < 2; ++ks) {
                bf16x8 pf[4], qf[4];
#pragma unroll
                for (int i = 0; i < 4; ++i) {
                    pf[i] = *(const bf16x8*)(pP + (wp * 64 + i * 16 + fr) * 144 + (ks * 32 + fq * 8) * 2);
                    qf[i] = *(const bf16x8*)(pQ + (wq * 64 + i * 16 + fr) * 144 + (ks * 32 + fq * 8) * 2);
                }
#pragma unroll
                for (int pi = 0; pi < 4; ++pi)
#pragma unroll
                    for (int qi = 0; qi < 4; ++qi) acc[pi][qi] = __builtin_amdgcn_mfma_f32_16x16x32_bf16(pf[pi], qf[qi], acc[pi][qi], 0, 0, 0);
            }
            if (more) {
                char* dX = smem + (buf ^ 1) * 36864;
#pragma unroll
                for (int i = 0; i < 4; ++i) {
                    *(u32x4*)(dX + (lrow + 32 * i) * 144 + lchk * 16) = ra[i];
                    *(u32x4*)(dX + 18432 + (lrow + 32 * i) * 144 + lchk * 16) = rw[i];
                }
            }
            __syncthreads();
        }
        if (vt_tile) {
            bf16_t* VT = (bf16_t*)(ws + OFF_VT);
            const int b = tm >> 5, s0 = (tm & 31) * 128 + wp * 64 + fq * 4;
            const int head = vt_head + wq;
#pragma unroll
            for (int pi = 0; pi < 4; ++pi)
#pragma unroll
                for (int qi = 0; qi < 4; ++qi) {
                    const int d = qi * 16 + fr;
                    u32x2 o; o.x = pk_bf16(acc[pi][qi][0], acc[pi][qi][1]); o.y = pk_bf16(acc[pi][qi][2], acc[pi][qi][3]);
                    *(u32x2*)(VT + ((size_t)((b * 16 + head) * 64 + d)) * 4096 + s0 + pi * 16) = o;
                }
        } else {
            const int tok0 = tm * 128 + wq * 64 + fr;
            const int nb0 = tn * 128 + wp * 64 + fq * 4;
            if (g.epi == EPI_RESID) {
#pragma unroll
                for (int qi = 0; qi < 4; ++qi) {
                    const size_t ro = (size_t)(tok0 + qi * 16) * DM;
#pragma unroll
                    for (int pi = 0; pi < 4; ++pi) {
                        const f32x4 xi = *(const f32x4*)(g.xin + ro + nb0 + pi * 16);
                        *(f32x4*)(g.xout + ro + nb0 + pi * 16) = xi + acc[pi][qi];
                    }
                }
            } else if (g.epi == EPI_SWIGLU) {
                bf16_t* ACT = (bf16_t*)(ws + OFF_ACT);
#pragma unroll
                for (int qi = 0; qi < 4; ++qi) {
                    bf16_t* rp = ACT + (size_t)(tok0 + qi * 16) * DFF;
#pragma unroll
                    for (int pp = 0; pp < 2; ++pp) {
                        const f32x4 gv = acc[2 * pp][qi], uv = acc[2 * pp + 1][qi];
                        float o[4];
#pragma unroll
                        for (int j = 0; j < 4; ++j) o[j] = gv[j] / (1.0f + __expf(-gv[j])) * uv[j];
                        u32x2 w; w.x = pk_bf16(o[0], o[1]); w.y = pk_bf16(o[2], o[3]);
                        *(u32x2*)(rp + 16 * (tn * 4 + wp * 2 + pp) + fq * 4) = w;
                    }
                }
            } else if (g.epi == EPI_EVIN && tn == 24) {
                if (wp == 0 && fq < 2) {
                    float* FA = (float*)(ws + OFF_FA);
#pragma unroll
                    for (int qi = 0; qi < 4; ++qi) *(f32x4*)(FA + (size_t)(tok0 + qi * 16) * 8 + fq * 4) = acc[0][qi];
                }
            } else {
                bf16_t* C; int ldc;
                if (g.epi == EPI_EVIN) { C = (bf16_t*)(ws + OFF_EB); ldc = 2048; }
                else if (g.epi == EPI_ODIN) { C = (bf16_t*)(ws + OFF_EB); ldc = 1536; }
                else if (g.epi == EPI_QB) { C = (bf16_t*)(ws + OFF_QD); ldc = 768; }
                else { C = (bf16_t*)(ws + OFF_KD); ldc = 768; }
#pragma unroll
                for (int qi = 0; qi < 4; ++qi) {
                    bf16_t* rp = C + (size_t)(tok0 + qi * 16) * ldc;
#pragma unroll
                    for (int pi = 0; pi < 4; ++pi) {
                        int col = nb0 + pi * 16;
                        if (g.epi == EPI_KVB) col = (col >> 6) * 96 + (col & 63);
                        u32x2 o; o.x = pk_bf16(acc[pi][qi][0], acc[pi][qi][1]); o.y = pk_bf16(acc[pi][qi][2], acc[pi][qi][3]);
                        *(u32x2*)(rp + col) = o;
                    }
                }
            }
        }
    }
}

template <int LPR, bool MEAN>
DEV void rownorm_block(bf16_t* buf, int ld, int col0, const float* __restrict__ gain, int row0, float* kmean_out, float* red) {
    constexpr int RPI = 256 / LPR;
    const int tid = TID, sub = tid % LPR, rr = tid / LPR;
    float g[8], am[8];
#pragma unroll
    for (int i = 0; i < 8; ++i) { g[i] = gain[sub * 8 + i]; am[i] = 0.f; }
    for (int it = 0; it < 256 / RPI; ++it) {
        bf16_t* rp = buf + (size_t)(row0 + it * RPI + rr) * ld + col0 + sub * 8;
        const u32x4 v = *(const u32x4*)rp;
        float x[8] = {bf_lo(v.x), bf_hi(v.x), bf_lo(v.y), bf_hi(v.y), bf_lo(v.z), bf_hi(v.z), bf_lo(v.w), bf_hi(v.w)};
        float ss = 0.f;
#pragma unroll
        for (int i = 0; i < 8; ++i) ss += x[i] * x[i];
#pragma unroll
        for (int o = 1; o < LPR; o <<= 1) ss += __shfl_xor(ss, o);
        const float rstd = rsqrtf(ss * (1.0f / (LPR * 8)) + EPS);
#pragma unroll
        for (int i = 0; i < 8; ++i) { x[i] = x[i] * rstd * g[i]; if (MEAN) am[i] += x[i]; }
        u32x4 o; o.x = pk_bf16(x[0], x[1]); o.y = pk_bf16(x[2], x[3]); o.z = pk_bf16(x[4], x[5]); o.w = pk_bf16(x[6], x[7]);
        *(u32x4*)rp = o;
    }
    if (MEAN) {
        __syncthreads();
#pragma unroll
        for (int i = 0; i < 8; ++i) red[rr * 64 + sub * 8 + i] = am[i];
        __syncthreads();
        if (tid < 64) {
            float s = 0.f;
            for (int r = 0; r < RPI; ++r) s += red[r * 64 + tid];
            kmean_out[tid] = s * (1.0f / 256.0f);
        }
    }
}

DEV void even_post(const Params& p, int li, char* smem) {
    char* ws = p.ws;
    bf16_t* EB = (bf16_t*)(ws + OFF_EB);
    float* red = (float*)smem;
    for (int it = BID; it < 2048 + 64; it += gridDim.x) {
        if (it < 2048) {
            const int blk = it >> 4, hh = it & 15;
            rownorm_block<8, false>(EB, 2048, hh * 64, (hh < 8 ? p.ev_qn : p.ev_kn) + li * 64, blk * 256, nullptr, red);
        } else {
            const int bh = it - 2048, b = bh >> 3, h = bh & 7, tid = TID, lane = tid & 63, wid = tid >> 6;
            const float* FA = (const float*)(ws + OFF_FA);
            float* CD = (float*)(ws + OFF_CDEC) + (size_t)bh * 4096;
            const float fb = p.ev_fb[li * 8 + h];
            float lf[16]; float run = 0.f;
#pragma unroll
            for (int i = 0; i < 16; ++i) {
                const float z = FA[(size_t)(b * 4096 + tid * 16 + i) * 8 + h] + fb;
                const float ls = fminf(z, 0.f) - log1pf(expf(-fabsf(z)));
                run += ls; lf[i] = run;
            }
            float inc = run;
#pragma unroll
            for (int o = 1; o < 64; o <<= 1) { const float y = __shfl_up(inc, o); if (lane >= o) inc += y; }
            __syncthreads();
            if (lane == 63) red[wid] = inc;
            __syncthreads();
            float base = inc - run;
            for (int w = 0; w < wid; ++w) base += red[w];
#pragma unroll
            for (int i = 0; i < 16; ++i) CD[tid * 16 + i] = (base + lf[i]) * LOG2E;
            __syncthreads();
        }
    }
}

DEV void odd_post1(const Params& p, int li, char* smem) {
    char* ws = p.ws;
    bf16_t* OB = (bf16_t*)(ws + OFF_EB);
    float* red = (float*)smem;
    float* KM = (float*)(ws + OFF_KMEAN);
    for (int it = BID; it < 2304; it += gridDim.x) {
        if (it < 1024) {
            const int blk = it >> 3, h = it & 7, b = blk >> 4, nb = blk & 15;
            rownorm_block<8, true>(OB, 1536, 512 + h * 64, p.od_mkn + li * 64, blk * 256, KM + (size_t)((b * 8 + h) * 16 + nb) * 64, red);
            __syncthreads();
        } else if (it < 2048) {
            const int j = it - 1024, blk = j >> 3, h = j & 7;
            rownorm_block<8, false>(OB, 1536, h * 64, p.od_mqn + li * 64, blk * 256, nullptr, red);
        } else if (it < 2176) {
            rownorm_block<32, false>(OB, 1536, 1024, p.od_qan + li * 256, (it - 2048) * 256, nullptr, red);
        } else {
            rownorm_block<16, false>(OB, 1536, 1280, p.od_kvan + li * 128, (it - 2176) * 256, nullptr, red);
        }
    }
}

DEV void moba_gate(const Params& p) {
    char* ws = p.ws;
    const bf16_t* OB = (const bf16_t*)(ws + OFF_EB);
    const float* KM = (const float*)(ws + OFF_KMEAN);
    int* SEL = (int*)(ws + OFF_SEL);
    const int gt = BID * blockDim.x + TID, gn = gridDim.x * blockDim.x;
    for (int w = gt; w < 8 * M_TOK; w += gn) {
        const int h = w >> 15, token = w & (M_TOK - 1), b = token >> 12, s = token & 4095, cur = s >> 8;
        float q[64];
        const u32x4* qp = (const u32x4*)(OB + (size_t)token * 1536 + h * 64);
#pragma unroll
        for (int i = 0; i < 8; ++i) { const u32x4 v = qp[i]; q[8 * i] = bf_lo(v.x); q[8 * i + 1] = bf_hi(v.x); q[8 * i + 2] = bf_lo(v.y); q[8 * i + 3] = bf_hi(v.y);
            q[8 * i + 4] = bf_lo(v.z); q[8 * i + 5] = bf_hi(v.z); q[8 * i + 6] = bf_lo(v.w); q[8 * i + 7] = bf_hi(v.w); }
        float v1 = -INFINITY, v2 = -INFINITY, v3 = -INFINITY; int i1 = -1, i2 = -1, i3 = -1;
        const float* kmb = KM + (size_t)((b * 8 + h) * 16) * 64;
        for (int n = 0; n < cur; ++n) {
            const f32x4* km = (const f32x4*)(kmb + n * 64);
            float d = 0.f;
#pragma unroll
            for (int i = 0; i < 16; ++i) { const f32x4 k4 = km[i]; d += q[4 * i] * k4[0] + q[4 * i + 1] * k4[1] + q[4 * i + 2] * k4[2] + q[4 * i + 3] * k4[3]; }
            if (d > v1) { v3 = v2; i3 = i2; v2 = v1; i2 = i1; v1 = d; i1 = n; }
            else if (d > v2) { v3 = v2; i3 = i2; v2 = d; i2 = n; }
            else if (d > v3) { v3 = d; i3 = n; }
        }
        int m = 0;
        if (i1 >= 0) m |= 1 << i1;
        if (i2 >= 0) m |= 1 << i2;
        if (i3 >= 0) m |= 1 << i3;
        SEL[(size_t)(b * 8 + h) * 4096 + s] = m;
    }
}

DEV void mla_post(const Params& p, int li) {
    char* ws = p.ws;
    bf16_t* QD = (bf16_t*)(ws + OFF_QD);
    bf16_t* KD = (bf16_t*)(ws + OFF_KD);
    const bf16_t* OB = (const bf16_t*)(ws + OFF_EB);
    const float* rope = (const float*)(ws + OFF_ROPE);
    const int gt = BID * blockDim.x + TID, gn = gridDim.x * blockDim.x;
    for (int w = gt; w < 2 * 8 * M_TOK; w += gn) {
        const int isk = w >> 18, rem = w & ((1 << 18) - 1), token = rem >> 3, h = rem & 7, s = token & 4095;
        bf16_t* rp = (isk ? KD : QD) + (size_t)token * 768 + h * 96;
        const float* gain = (isk ? p.od_lkn : p.od_lqn) + li * 96;
        float x[96];
#pragma unroll
        for (int i = 0; i < 12; ++i) {
            u32x4 v;
            if (isk && i >= 8) v = *(const u32x4*)(OB + (size_t)token * 1536 + 1408 + (i - 8) * 8);
            else v = *(const u32x4*)(rp + i * 8);
            x[8 * i] = bf_lo(v.x); x[8 * i + 1] = bf_hi(v.x); x[8 * i + 2] = bf_lo(v.y); x[8 * i + 3] = bf_hi(v.y);
            x[8 * i + 4] = bf_lo(v.z); x[8 * i + 5] = bf_hi(v.z); x[8 * i + 6] = bf_lo(v.w); x[8 * i + 7] = bf_hi(v.w);
        }
        float ss = 0.f;
#pragma unroll
        for (int i = 0; i < 96; ++i) ss += x[i] * x[i];
        const float rstd = rsqrtf(ss * (1.0f / 96.0f) + EPS);
#pragma unroll
        for (int i = 0; i < 96; ++i) x[i] = x[i] * rstd * gain[i];
        const float* cs = rope + (size_t)s * 16;
        const float* sn = rope + 4096 * 16 + (size_t)s * 16;
#pragma unroll
        for (int i = 0; i < 16; ++i) {
            const float c = cs[i], sv = sn[i], a = x[64 + i], bb = x[80 + i];
            x[64 + i] = a * c - bb * sv; x[80 + i] = a * sv + bb * c;
        }
#pragma unroll
        for (int i = 0; i < 12; ++i) {
            u32x4 o; o.x = pk_bf16(x[8 * i], x[8 * i + 1]); o.y = pk_bf16(x[8 * i + 2], x[8 * i + 3]); o.z = pk_bf16(x[8 * i + 4], x[8 * i + 5]); o.w = pk_bf16(x[8 * i + 6], x[8 * i + 7]);
            *(u32x4*)(rp + i * 8) = o;
        }
    }
}

enum { AT_FOX = 0, AT_SB, AT_MOBA, AT_MLA };
constexpr int AT_KBUF = 13312, AT_VBUF = 8192, AT_K0 = 0, AT_V0 = 2 * AT_KBUF, AT_MISC = AT_V0 + 2 * AT_VBUF;

template <int MODE>
DEV void attn_item(const Params& p, char* smem, int b, int h, int qt) {
    constexpr int DQK = (MODE == AT_MLA) ? 96 : 64;
    constexpr int NKS = DQK / 32;
    constexpr int KSTRB = (DQK + 8) * 2;
    constexpr int KCH = DQK / 8;
    constexpr int KLD = (64 * KCH) / 256;
    char* ws = p.ws;
    const int tid = TID, wid = tid >> 6, lane = tid & 63, fr = lane & 15, fq = lane >> 4;
    const bf16_t* Qb; const bf16_t* Kb; int ldq; int head16;
    if (MODE == AT_FOX) { Qb = (const bf16_t*)(ws + OFF_EB) + h * 64; Kb = Qb + 512; ldq = 2048; head16 = h; }
    else if (MODE == AT_SB) { Qb = (const bf16_t*)(ws + OFF_EB) + 1024 + h * 64; Kb = Qb + 512; ldq = 2048; head16 = 8 + h; }
    else if (MODE == AT_MOBA) { Qb = (const bf16_t*)(ws + OFF_EB) + h * 64; Kb = Qb + 512; ldq = 1536; head16 = h; }
    else { Qb = (const bf16_t*)(ws + OFF_QD) + h * 96; Kb = (const bf16_t*)(ws + OFF_KD) + h * 96; ldq = 768; head16 = 8 + h; }
    const bf16_t* Vt = (const bf16_t*)(ws + OFF_VT) + (size_t)((b * 16 + head16) * 64) * 4096;
    const size_t tokb = (size_t)b * 4096;
    const int qpos = qt * 64 + wid * 16 + fr;
    int* smi = (int*)(smem + AT_MISC);
    float* btab = (float*)(smem + AT_MISC + 512);

    __syncthreads();
    int mysel = 0;
    if (MODE == AT_MOBA) {
        mysel = ((const int*)(ws + OFF_SEL))[(size_t)(b * 8 + h) * 4096 + qpos];
        if (tid == 0) smi[73] = 0;
        if (tid < 128) btab[tid] = ((const float*)(ws + OFF_BTAB))[h * 128 + tid];
        __syncthreads();
        if (fq == 0) atomicOr(&smi[73], mysel);
        __syncthreads();
    }
    if (tid == 0) {
        int n = 0;
        if (MODE == AT_FOX || MODE == AT_MLA) { for (int t = 0; t <= qt; ++t) smi[n++] = t; }
        else if (MODE == AT_SB) { for (int t = qt; t >= 0; --t) smi[n++] = t; }
        else {
            const int cur = qt >> 2, um = smi[73];
            for (int t = cur * 4; t <= qt; ++t) smi[n++] = t;
            for (int kb = 0; kb < cur; ++kb) if ((um >> kb) & 1) { for (int t = 0; t < 4; ++t) smi[n++] = kb * 4 + t; }
        }
        smi[72] = n;
    }
    __syncthreads();
    const int nt = smi[72];

    bf16x8 qf[NKS];
    {
        const bf16_t* qp = Qb + (tokb + qpos) * ldq + fq * 8;
#pragma unroll
        for (int ks = 0; ks < NKS; ++ks) qf[ks] = *(const bf16x8*)(qp + ks * 32);
    }
    float cq = 0.f;
    const float* CD = (const float*)(ws + OFF_CDEC) + (size_t)(b * 8 + h) * 4096;
    if (MODE == AT_FOX) cq = CD[qpos];
    const float c1 = (MODE == AT_MLA ? 0.10206207261596577f : 0.125f) * (MODE == AT_SB ? 1.0f : LOG2E);

    f32x4 o[4];
#pragma unroll
    for (int i = 0; i < 4; ++i) o[i] = (f32x4){0.f, 0.f, 0.f, 0.f};
    float mrun = -1e30f, lsum = 0.f, R = 0.f;

    u32x4 rk[KLD], rv[2];
    auto gload = [&](int tile) {
#pragma unroll
        for (int i = 0; i < KLD; ++i) { const int idx = tid + 256 * i, r = idx / KCH, c = idx % KCH; rk[i] = *(const u32x4*)(Kb + (tokb + tile * 64 + r) * ldq + c * 8); }
#pragma unroll
        for (int i = 0; i < 2; ++i) { const int idx = tid + 256 * i, d = idx >> 3, c8 = idx & 7; rv[i] = *(const u32x4*)(Vt + (size_t)d * 4096 + tile * 64 + c8 * 8); }
    };
    auto lstore = [&](int buf) {
        char* kb = smem + AT_K0 + buf * AT_KBUF; char* vb = smem + AT_V0 + buf * AT_VBUF;
#pragma unroll
        for (int i = 0; i < KLD; ++i) { const int idx = tid + 256 * i, r = idx / KCH, c = idx % KCH; *(u32x4*)(kb + r * KSTRB + c * 16) = rk[i]; }
#pragma unroll
        for (int i = 0; i < 2; ++i) { const int idx = tid + 256 * i, d = idx >> 3, c8 = idx & 7; *(u32x4*)(vb + ((c8 >> 1) * 64 + d) * 32 + (c8 & 1) * 16) = rv[i]; }
    };
    gload(smi[0]); lstore(0);
    __syncthreads();
    for (int it = 0; it < nt; ++it) {
        const int tile = smi[it], buf = it & 1;
        const bool more = it + 1 < nt;
        if (more) gload(smi[it + 1]);
        const char* kb = smem + AT_K0 + buf * AT_KBUF; const char* vb = smem + AT_V0 + buf * AT_VBUF;
        f32x4 s[4];
#pragma unroll
        for (int kt = 0; kt < 4; ++kt) {
            s[kt] = (f32x4){0.f, 0.f, 0.f, 0.f};
#pragma unroll
            for (int ks = 0; ks < NKS; ++ks) {
                const bf16x8 kf = *(const bf16x8*)(kb + (kt * 16 + fr) * KSTRB + (ks * 32 + fq * 8) * 2);
                s[kt] = __builtin_amdgcn_mfma_f32_16x16x32_bf16(kf, qf[ks], s[kt], 0, 0, 0);
            }
        }
        const int kbase = tile * 64 + fq * 4;
        const bool diag = (tile == qt);
        unsigned pp[4][2];
        if (MODE == AT_SB) {
            float T[4], exq[4], ls[4][4], e[4][4];
#pragma unroll
            for (int kt = 0; kt < 4; ++kt) {
                float v[4];
#pragma unroll
                for (int j = 0; j < 4; ++j) {
                    const float z = s[kt][j] * c1;
                    const float sp = __logf(1.0f + __expf(-fabsf(z)));
                    const float l = fminf(z, 0.f) - sp;
                    const bool strict = !diag || (kbase + kt * 16 + j < qpos);
                    ls[kt][j] = strict ? l : -INFINITY;
                    v[j] = strict ? (l - z) : 0.f;
                }
                e[kt][3] = 0.f; e[kt][2] = v[3]; e[kt][1] = v[3] + v[2]; e[kt][0] = e[kt][1] + v[1];
                const float G = e[kt][0] + v[0];
#if DBG_NOSHFL
                exq[kt] = 0.f; T[kt] = G;
#else
                float xs = G;
                float y = __shfl_down(xs, 16); if (fq < 3) xs += y;
                y = __shfl_down(xs, 32); if (fq < 2) xs += y;
                exq[kt] = xs - G;
                T[kt] = __shfl(xs, fr);
#endif
            }
            float off = R;
#pragma unroll
            for (int kt = 3; kt >= 0; --kt) {
                float w[4];
#pragma unroll
                for (int j = 0; j < 4; ++j) w[j] = __expf(ls[kt][j] + off + exq[kt] + e[kt][j]);
                pp[kt][0] = pk_bf16(w[0], w[1]); pp[kt][1] = pk_bf16(w[2], w[3]);
                off += T[kt];
            }
            R = off;
        } else {
            float t[4][4];
            float mx = -1e30f;
#pragma unroll
            for (int kt = 0; kt < 4; ++kt) {
                f32x4 bias = (f32x4){0.f, 0.f, 0.f, 0.f};
                if (MODE == AT_FOX) { const f32x4 ck = *(const f32x4*)(CD + kbase + kt * 16); bias = (f32x4){cq, cq, cq, cq} - ck; }
                bool blk_ok = true;
                if (MODE == AT_MOBA) {
                    blk_ok = diag || (tile >> 2) == (qt >> 2) || ((mysel >> (tile >> 2)) & 1);
#pragma unroll
                    for (int j = 0; j < 4; ++j) { int dist = qpos - (kbase + kt * 16 + j); dist = dist < 0 ? 0 : (dist > 127 ? 127 : dist); bias[j] = btab[dist]; }
                }
#pragma unroll
                for (int j = 0; j < 4; ++j) {
                    float v = s[kt][j] * c1 + bias[j];
                    const bool ok = blk_ok && (!diag || (kbase + kt * 16 + j <= qpos));
                    v = ok ? v : -1e30f;
                    t[kt][j] = v; mx = fmaxf(mx, v);
                }
            }
            mx = fmaxf(mx, __shfl_xor(mx, 16)); mx = fmaxf(mx, __shfl_xor(mx, 32));
            const float mnew = fmaxf(mrun, mx);
            const float alpha = exp2f(mrun - mnew);
            mrun = mnew;
            float ps = 0.f;
#pragma unroll
            for (int kt = 0; kt < 4; ++kt) {
                float w[4];
#pragma unroll
                for (int j = 0; j < 4; ++j) { w[j] = exp2f(t[kt][j] - mnew); ps += w[j]; }
                pp[kt][0] = pk_bf16(w[0], w[1]); pp[kt][1] = pk_bf16(w[2], w[3]);
            }
            lsum = lsum * alpha + ps;
#pragma unroll
            for (int i = 0; i < 4; ++i) o[i] = o[i] * alpha;
        }
#pragma unroll
        for (int kk = 0; kk < 2; ++kk) {
            u32x4 pw; pw.x = pp[2 * kk][0]; pw.y = pp[2 * kk][1]; pw.z = pp[2 * kk + 1][0]; pw.w = pp[2 * kk + 1][1];
            const bf16x8 pf = __builtin_bit_cast(bf16x8, pw);
#pragma unroll
            for (int dt = 0; dt < 4; ++dt) {
                const u32x2 lo = *(const u32x2*)(vb + ((2 * kk) * 64 + dt * 16 + fr) * 32 + fq * 8);
                const u32x2 hi = *(const u32x2*)(vb + ((2 * kk + 1) * 64 + dt * 16 + fr) * 32 + fq * 8);
                u32x4 vw; vw.x = lo.x; vw.y = lo.y; vw.z = hi.x; vw.w = hi.y;
                o[dt] = __builtin_amdgcn_mfma_f32_16x16x32_bf16(__builtin_bit_cast(bf16x8, vw), pf, o[dt], 0, 0, 0);
            }
        }
        if (more) lstore(buf ^ 1);
        if (MODE == AT_SB && !NO_SB_EXIT) {
            if (__syncthreads_and(R < -40.0f)) break;
        } else {
            __syncthreads();
        }
    }
    float inv = 1.0f;
    if (MODE != AT_SB) {
        float l = lsum; l += __shfl_xor(l, 16); l += __shfl_xor(l, 32);
        inv = 1.0f / l;
    }
    bf16_t* op = (bf16_t*)(ws + OFF_HM) + (tokb + qpos) * 1024 + head16 * 64 + fq * 4;
#pragma unroll
    for (int dt = 0; dt < 4; ++dt) {
        float q0 = o[dt][0] * inv, q1 = o[dt][1] * inv, q2 = o[dt][2] * inv, q3 = o[dt][3] * inv;
        if (!(fabsf(q0) < 1e30f)) q0 = 777.f; if (!(fabsf(q1) < 1e30f)) q1 = 777.f; if (!(fabsf(q2) < 1e30f)) q2 = 777.f; if (!(fabsf(q3) < 1e30f)) q3 = 777.f;
        u32x2 w; w.x = pk_bf16(q0, q1); w.y = pk_bf16(q2, q3);
        *(u32x2*)(op + dt * 16) = w;
    }
}

DEV void attn_phase(const Params& p, char* smem, bool even) {
    for (int it = BID; it < 64 * 128; it += gridDim.x) {
        const int qt = 63 - (it >> 7), bh = it & 127, b = bh >> 4, h16 = bh & 15;
        if (even) { if (h16 < 8) { if (!DBG_SKIP_FOX) attn_item<AT_FOX>(p, smem, b, h16, qt); } else if (!DBG_SKIP_SB) attn_item<AT_SB>(p, smem, b, h16 - 8, qt); }
        else { if (h16 < 8) attn_item<AT_MOBA>(p, smem, b, h16, qt); else attn_item<AT_MLA>(p, smem, b, h16 - 8, qt); }
    }
}

DEV void gsync(unsigned* ctr, unsigned& target) {
    __builtin_amdgcn_fence(__ATOMIC_RELEASE, "agent");
    __syncthreads();
    target += gridDim.x;
    if (threadIdx.x == 0) {
        __hip_atomic_fetch_add(ctr, 1u, __ATOMIC_RELEASE, __HIP_MEMORY_SCOPE_AGENT);
        while (__hip_atomic_load(ctr, __ATOMIC_ACQUIRE, __HIP_MEMORY_SCOPE_AGENT) < target) __builtin_amdgcn_s_sleep(4);
    }
    __syncthreads();
    __builtin_amdgcn_fence(__ATOMIC_ACQUIRE, "agent");
}

enum { OP_NORM_MIX = 0, OP_GEMM_IN, OP_EPOST, OP_OPOST1, OP_GEMM_QB, OP_GEMM_KVB, OP_GATE, OP_MLAPOST, OP_ATTN, OP_GEMM_OUT, OP_NORM_FFN, OP_GEMM_GU, OP_GEMM_DN };

__global__ void __launch_bounds__(256, 2) fwd_megakernel(Params p) {
    extern __shared__ __attribute__((aligned(16))) char smem[];
    cg::grid_group grid = cg::this_grid();
    char* ws = p.ws;
    unsigned* bar = (unsigned*)(ws + OFF_BAR);
    unsigned btarget = 0;
    grid.sync();
    prologue(p, smem);
    gsync(bar, btarget);
    int gstep = 0;
    for (int layer = 0; layer < 4; ++layer) {
        const int li = layer >> 1;
        const bool even = (layer & 1) == 0;
        const float* xin = layer == 0 ? p.x : p.out;
        const int nsteps = even ? 8 : 12;
        for (int step = 0; step < nsteps; ++step) {
#ifdef DBG_STEPS
            if (gstep >= DBG_STEPS) break;
#endif
            ++gstep;
            int op; bool sync = true;
            if (even) {
                switch (step) { case 0: op = OP_NORM_MIX; break; case 1: op = OP_GEMM_IN; break; case 2: op = OP_EPOST; break; case 3: op = OP_ATTN; break;
                                case 4: op = OP_GEMM_OUT; break; case 5: op = OP_NORM_FFN; break; case 6: op = OP_GEMM_GU; break; default: op = OP_GEMM_DN; break; }
            } else {
                switch (step) { case 0: op = OP_NORM_MIX; break; case 1: op = OP_GEMM_IN; break; case 2: op = OP_OPOST1; break; case 3: op = OP_GEMM_QB; break;
                                case 4: op = OP_GEMM_KVB; break; case 5: op = OP_GATE; break; case 6: op = OP_MLAPOST; break; case 7: op = OP_ATTN; break;
                                case 8: op = OP_GEMM_OUT; break; case 9: op = OP_NORM_FFN; break; case 10: op = OP_GEMM_GU; break; default: op = OP_GEMM_DN; break; }
            }
            if (op == OP_GEMM_QB || op == OP_GEMM_KVB) sync = false;
            switch (op) {
            case OP_NORM_MIX: norm_phase(xin, (even ? p.ev_norm : p.od_norm) + li * DM, (bf16_t*)(ws + OFF_HM)); break;
            case OP_NORM_FFN: norm_phase(p.out, p.ffn_norm + layer * DM, (bf16_t*)(ws + OFF_HM)); break;
            case OP_EPOST: even_post(p, li, smem); break;
            case OP_OPOST1: odd_post1(p, li, smem); break;
            case OP_GATE: moba_gate(p); break;
            case OP_MLAPOST: mla_post(p, li); break;
            case OP_ATTN: attn_phase(p, smem, even); break;
            default: {
                GemmP g; g.xin = nullptr; g.xout = nullptr;
                if (op == OP_GEMM_IN) {
                    g.A = (const bf16_t*)(ws + OFF_HM); g.lda = 1024; g.K = 1024;
                    if (even) { g.Bt = (const bf16_t*)(ws + OFF_EVIN) + li * SZ_EVIN; g.nN = 25; g.epi = EPI_EVIN; }
                    else { g.Bt = (const bf16_t*)(ws + OFF_ODIN) + li * SZ_ODIN; g.nN = 16; g.epi = EPI_ODIN; }
                } else if (op == OP_GEMM_QB) {
                    g.A = (const bf16_t*)(ws + OFF_EB) + 1024; g.lda = 1536; g.K = 256; g.Bt = (const bf16_t*)(ws + OFF_QB) + li * SZ_QB; g.nN = 6; g.epi = EPI_QB;
                } else if (op == OP_GEMM_KVB) {
                    g.A = (const bf16_t*)(ws + OFF_EB) + 1280; g.lda = 1536; g.K = 128; g.Bt = (const bf16_t*)(ws + OFF_KVB) + li * SZ_KVB; g.nN = 8; g.epi = EPI_KVB;
                } else if (op == OP_GEMM_OUT) {
                    g.A = (const bf16_t*)(ws + OFF_HM); g.lda = 1024; g.K = 1024; g.Bt = (const bf16_t*)(ws + (even ? OFF_EVOUT : OFF_ODOUT)) + li * SZ_OUT; g.nN = 8; g.epi = EPI_RESID;
                    g.xin = xin; g.xout = p.out;
                } else if (op == OP_GEMM_GU) {
                    g.A = (const bf16_t*)(ws + OFF_HM); g.lda = 1024; g.K = 1024; g.Bt = (const bf16_t*)(ws + OFF_GU) + layer * SZ_GU; g.nN = 44; g.epi = EPI_SWIGLU;
                } else {
                    g.A = (const bf16_t*)(ws + OFF_ACT); g.lda = DFF; g.K = DFF; g.Bt = (const bf16_t*)(ws + OFF_DN) + layer * SZ_DN; g.nN = 8; g.epi = EPI_RESID;
                    g.xin = p.out; g.xout = p.out;
                }
                gemm_phase(g, smem, ws);
            } break;
            }
            if (sync) gsync(bar, btarget);
        }
    }
#ifdef DBG_STEPS
    gsync(bar, btarget);
    {
        const size_t n = (size_t)M_TOK * 1024;
        const bf16_t* b0 = (const bf16_t*)(ws + OFF_HM);
        const bf16_t* b1 = (const bf16_t*)(ws + DBG_OFF1);
        const bf16_t* b2 = (const bf16_t*)(ws + DBG_OFF2);
        const bf16_t* b3 = (const bf16_t*)(ws + OFF_EB + (size_t)M_TOK * 1024 * 2);
        for (size_t i = (size_t)blockIdx.x * 256 + threadIdx.x; i < n; i += (size_t)gridDim.x * 256) {
            float v = bf_lo(b0[i]) + bf_lo(b1[i]) + bf_lo(b2[i]) + bf_lo(b3[i]);
            if (DBG_STEPS >= 5) v += p.out[i];
            p.out[i] = v;
        }
    }
#endif
}

extern "C" void kernel_launch(void* const* d_in, const int* in_sizes, int n_in, void* d_out, int out_size, void* d_ws, size_t ws_size,
                              hipStream_t stream) {
    if (ws_size < OFF_END + 256) return;
    static int grid_blocks = 0;
    if (!grid_blocks) {
        int dev = 0, cus = 0, per_cu = 0;
        hipGetDevice(&dev);
        hipDeviceGetAttribute(&cus, hipDeviceAttributeMultiprocessorCount, dev);
        hipFuncSetAttribute((const void*)fwd_megakernel, hipFuncAttributeMaxDynamicSharedMemorySize, SMEM_BYTES);
        hipOccupancyMaxActiveBlocksPerMultiprocessor(&per_cu, fwd_megakernel, 256, SMEM_BYTES);
        if (per_cu > 2) per_cu = 2;
        if (per_cu < 1) per_cu = 1;
        grid_blocks = cus * per_cu;
    }
    Params p{};
    p.x = (const float*)d_in[0]; p.ffn_norm = (const float*)d_in[1]; p.w_gu = (const float*)d_in[2]; p.w_dn = (const float*)d_in[3];
    p.rel_bias = (const float*)d_in[4]; p.ev_norm = (const float*)d_in[5]; p.ev_w_in = (const float*)d_in[6]; p.ev_fb = (const float*)d_in[7];
    p.ev_qn = (const float*)d_in[8]; p.ev_kn = (const float*)d_in[9]; p.ev_w_out = (const float*)d_in[10]; p.od_norm = (const float*)d_in[11];
    p.od_w_in = (const float*)d_in[12]; p.od_mqn = (const float*)d_in[13]; p.od_mkn = (const float*)d_in[14]; p.od_qan = (const float*)d_in[15];
    p.od_wqb = (const float*)d_in[16]; p.od_kvan = (const float*)d_in[17]; p.od_wkvb = (const float*)d_in[18]; p.od_lqn = (const float*)d_in[19];
    p.od_lkn = (const float*)d_in[20]; p.od_w_out = (const float*)d_in[21];
    p.out = (float*)d_out; p.ws = (char*)d_ws;
    hipMemsetAsync((char*)d_ws + OFF_BAR, 0, 256, stream);
    void* args[] = {&p};
    hipError_t e = hipLaunchCooperativeKernel((void*)fwd_megakernel, dim3(grid_blocks), dim3(256), args, SMEM_BYTES, stream);
    if (e != hipSuccess) fprintf(stderr, "cooperative launch failed: %s (grid %d)\n", hipGetErrorString(e), grid_blocks);
}

#ifdef PHASE_TEST
__global__ void __launch_bounds__(256, 2) t_prologue(Params p) { extern __shared__ __attribute__((aligned(16))) char smem[]; prologue(p, smem); }
__global__ void __launch_bounds__(256, 2) t_norm(Params p) { norm_phase(p.x, p.ev_norm, (bf16_t*)p.ws); }
__global__ void __launch_bounds__(256, 2) t_gemm(Params p, GemmP g) { extern __shared__ __attribute__((aligned(16))) char smem[]; gemm_phase(g, smem, p.ws); }
__global__ void __launch_bounds__(256, 2) t_epost(Params p) { extern __shared__ __attribute__((aligned(16))) char smem[]; even_post(p, 0, smem); }
__global__ void __launch_bounds__(256, 2) t_opost(Params p) { extern __shared__ __attribute__((aligned(16))) char smem[]; odd_post1(p, 0, smem); }
__global__ void __launch_bounds__(256, 2) t_gate(Params p) { moba_gate(p); }
__global__ void __launch_bounds__(256, 2) t_mlapost(Params p) { mla_post(p, 0); }
__global__ void __launch_bounds__(256, 2) t_attn_fox(Params p) { extern __shared__ __attribute__((aligned(16))) char smem[]; attn_item<AT_FOX>(p, smem, 0, 0, blockIdx.x); }
__global__ void __launch_bounds__(256, 2) t_attn_sb(Params p) { extern __shared__ __attribute__((aligned(16))) char smem[]; attn_item<AT_SB>(p, smem, 0, 0, blockIdx.x); }
__global__ void __launch_bounds__(256, 2) t_attn_moba(Params p) { extern __shared__ __attribute__((aligned(16))) char smem[]; attn_item<AT_MOBA>(p, smem, 0, 0, blockIdx.x); }
__global__ void __launch_bounds__(256, 2) t_attn_mla(Params p) { extern __shared__ __attribute__((aligned(16))) char smem[]; attn_item<AT_MLA>(p, smem, 0, 0, blockIdx.x); }
#endif
```

```cpp
#include <hip/hip_runtime.h>
#include <hip/hip_cooperative_groups.h>
#include <cstdio>
#include <cstdint>
namespace cg = cooperative_groups;

typedef unsigned short bf16_t;
typedef short bf16x8 __attribute__((ext_vector_type(8)));
typedef float f32x4 __attribute__((ext_vector_type(4)));
typedef unsigned u32x4 __attribute__((ext_vector_type(4)));
typedef unsigned u32x2 __attribute__((ext_vector_type(2)));

#define DEV __device__ __forceinline__
#define NO_SB_EXIT 0
#define DBG_REP_ATTN 1
#define DBG_REP_GU 2
#define DBG_SKIP_SB 0
#define DBG_NOSHFL 0
#define DBG_SKIP_FOX 0
#define DBG_OFF1 OFF_EB
#define DBG_OFF2 OFF_VT

constexpr int M_TOK = 32768, SEQ = 4096, DM = 1024, DFF = 2816;
constexpr float EPS = 1e-6f;
constexpr float LOG2E = 1.4426950408889634f;

constexpr size_t SZ_EVIN = 3200ull * 1024, SZ_ODIN = 2048ull * 1024, SZ_OUT = 1024ull * 1024, SZ_GU = 5632ull * 1024,
                 SZ_DN = 1024ull * 2816, SZ_QB = 768ull * 256, SZ_KVB = 1024ull * 128;
constexpr size_t OFF_EVIN = 0;
constexpr size_t OFF_ODIN = OFF_EVIN + 2 * SZ_EVIN * 2;
constexpr size_t OFF_EVOUT = OFF_ODIN + 2 * SZ_ODIN * 2;
constexpr size_t OFF_ODOUT = OFF_EVOUT + 2 * SZ_OUT * 2;
constexpr size_t OFF_GU = OFF_ODOUT + 2 * SZ_OUT * 2;
constexpr size_t OFF_DN = OFF_GU + 4 * SZ_GU * 2;
constexpr size_t OFF_QB = OFF_DN + 4 * SZ_DN * 2;
constexpr size_t OFF_KVB = OFF_QB + 2 * SZ_QB * 2;
constexpr size_t OFF_HM = OFF_KVB + 2 * SZ_KVB * 2;
constexpr size_t OFF_EB = OFF_HM + (size_t)M_TOK * 1024 * 2;
constexpr size_t OFF_VT = OFF_EB + (size_t)M_TOK * 2048 * 2;
constexpr size_t OFF_QD = OFF_VT + (size_t)M_TOK * 1024 * 2;
constexpr size_t OFF_KD = OFF_QD + (size_t)M_TOK * 768 * 2;
constexpr size_t OFF_FA = OFF_KD + (size_t)M_TOK * 768 * 2;
constexpr size_t OFF_CDEC = OFF_FA + (size_t)M_TOK * 8 * 4;
constexpr size_t OFF_KMEAN = OFF_CDEC + 64ull * 4096 * 4;
constexpr size_t OFF_SEL = OFF_KMEAN + 8ull * 8 * 16 * 64 * 4;
constexpr size_t OFF_BTAB = OFF_SEL + 64ull * 4096 * 4;
constexpr size_t OFF_ROPE = OFF_BTAB + 8ull * 128 * 4;
constexpr size_t OFF_END = OFF_ROPE + 2ull * 4096 * 16 * 4;
constexpr size_t OFF_BAR = OFF_END;
constexpr size_t OFF_ACT = OFF_EB;
static_assert((size_t)M_TOK * DFF * 2 <= (size_t)M_TOK * 3072 * 2, "ACT overlay");

constexpr int SMEM_BYTES = 73728;

struct Params {
    const float* x; const float* ffn_norm; const float* w_gu; const float* w_dn; const float* rel_bias;
    const float* ev_norm; const float* ev_w_in; const float* ev_fb; const float* ev_qn; const float* ev_kn; const float* ev_w_out;
    const float* od_norm; const float* od_w_in; const float* od_mqn; const float* od_mkn; const float* od_qan; const float* od_wqb;
    const float* od_kvan; const float* od_wkvb; const float* od_lqn; const float* od_lkn; const float* od_w_out;
    float* out; char* ws;
};

typedef __bf16 bf16v2_t __attribute__((ext_vector_type(2)));
typedef float f32x2_t __attribute__((ext_vector_type(2)));
DEV unsigned pk_bf16(float lo, float hi) { f32x2_t v = {lo, hi}; bf16v2_t b = __builtin_convertvector(v, bf16v2_t); return __builtin_bit_cast(unsigned, b); }
DEV int opq_v(int x) { asm volatile("" : "+v"(x)); return x; }
DEV int opq_s(int x) { asm volatile("" : "+s"(x)); return x; }
#define TID opq_v((int)threadIdx.x)
#define BID opq_s((int)blockIdx.x)
DEV float bf_lo(unsigned u) { return __uint_as_float(u << 16); }
DEV float bf_hi(unsigned u) { return __uint_as_float(u & 0xffff0000u); }

enum { WM_ID = 0, WM_EVIN, WM_ODIN, WM_GU, WM_KVB };
DEV int srcmap(int mode, int n) {
    switch (mode) {
    case WM_EVIN:
        if (n < 1024) return n;
        if (n < 1536) return 1544 + (n - 1024);
        if (n < 2048) return 2056 + (n - 1536);
        if (n < 2560) return 1024 + (n - 2048);
        if (n < 3072) return 2568 + (n - 2560);
        if (n < 3080) return 1536 + (n - 3072);
        return -1;
    case WM_ODIN:
        if (n < 1024) return n;
        if (n < 1280) return 1536 + (n - 1024);
        if (n < 1408) return 1792 + (n - 1280);
        if (n < 1440) return 1920 + (n - 1408);
        if (n < 1536) return -1;
        return 1024 + (n - 1536);
    case WM_GU: { int i = n >> 5, t = n & 31; return t < 16 ? 16 * i + t : 2816 + 16 * i + (t - 16); }
    case WM_KVB: { if (n < 512) return (n >> 6) * 128 + (n & 63); int m = n - 512; return (m >> 6) * 128 + 64 + (m & 63); }
    default: return n;
    }
}

DEV void convert_matrix(const float* __restrict__ W, bf16_t* __restrict__ Bt, int K, int N, int Np, int mode, float* lds) {
    const int tid = TID;
    const int nkt = K >> 6, ntiles = (Np >> 6) * nkt;
    for (int t = BID; t < ntiles; t += gridDim.x) {
        const int k0 = (t % nkt) << 6, n0 = (t / nkt) << 6;
        const int nn = tid & 63, src = srcmap(mode, n0 + nn);
        __syncthreads();
#pragma unroll 4
        for (int i = 0; i < 16; ++i) {
            const int kk = (tid >> 6) + 4 * i;
            lds[nn * 65 + kk] = src >= 0 ? W[(size_t)(k0 + kk) * N + src] : 0.f;
        }
        __syncthreads();
        const int r = tid >> 2, c = tid & 3;
        const float* lp = lds + r * 65 + c * 16;
        u32x4 a, b;
        a.x = pk_bf16(lp[0], lp[1]); a.y = pk_bf16(lp[2], lp[3]); a.z = pk_bf16(lp[4], lp[5]); a.w = pk_bf16(lp[6], lp[7]);
        b.x = pk_bf16(lp[8], lp[9]); b.y = pk_bf16(lp[10], lp[11]); b.z = pk_bf16(lp[12], lp[13]); b.w = pk_bf16(lp[14], lp[15]);
        bf16_t* dp = Bt + (size_t)(n0 + r) * K + k0 + c * 16;
        *(u32x4*)dp = a; *(u32x4*)(dp + 8) = b;
    }
}

DEV void prologue(const Params& p, char* smem) {
    float* lds = (float*)smem;
    char* ws = p.ws;
    for (int i = 0; i < 2; ++i) {
        convert_matrix(p.ev_w_in + (size_t)i * 1024 * 3080, (bf16_t*)(ws + OFF_EVIN) + i * SZ_EVIN, 1024, 3080, 3200, WM_EVIN, lds);
        convert_matrix(p.od_w_in + (size_t)i * 1024 * 1952, (bf16_t*)(ws + OFF_ODIN) + i * SZ_ODIN, 1024, 1952, 2048, WM_ODIN, lds);
        convert_matrix(p.ev_w_out + (size_t)i * 1024 * 1024, (bf16_t*)(ws + OFF_EVOUT) + i * SZ_OUT, 1024, 1024, 1024, WM_ID, lds);
        convert_matrix(p.od_w_out + (size_t)i * 1024 * 1024, (bf16_t*)(ws + OFF_ODOUT) + i * SZ_OUT, 1024, 1024, 1024, WM_ID, lds);
        convert_matrix(p.od_wqb + (size_t)i * 256 * 768, (bf16_t*)(ws + OFF_QB) + i * SZ_QB, 256, 768, 768, WM_ID, lds);
        convert_matrix(p.od_wkvb + (size_t)i * 128 * 1024, (bf16_t*)(ws + OFF_KVB) + i * SZ_KVB, 128, 1024, 1024, WM_KVB, lds);
    }
    for (int l = 0; l < 4; ++l) {
        convert_matrix(p.w_gu + (size_t)l * 1024 * 5632, (bf16_t*)(ws + OFF_GU) + l * SZ_GU, 1024, 5632, 5632, WM_GU, lds);
        convert_matrix(p.w_dn + (size_t)l * 2816 * 1024, (bf16_t*)(ws + OFF_DN) + l * SZ_DN, 2816, 1024, 1024, WM_ID, lds);
    }
    const int gt = BID * blockDim.x + TID, gn = gridDim.x * blockDim.x;
    float* btab = (float*)(ws + OFF_BTAB);
    for (int i = gt; i < 8 * 128; i += gn) {
        const int h = i >> 7, n = i & 127;
        int bucket;
        if (n < 16) bucket = n;
        else { const float v = logf((float)n / 16.0f) / 2.0794415416798357f * 16.0f; bucket = 16 + (int)v; if (bucket > 31) bucket = 31; }
        btab[i] = p.rel_bias[h * 32 + bucket] * LOG2E;
    }
    float* rope = (float*)(ws + OFF_ROPE);
    for (int i = gt; i < 4096 * 16; i += gn) {
        const int pos = i >> 4, f = i & 15;
        const float inv = powf(10000.0f, -(float)f / 16.0f);
        const float ang = (float)pos * inv;
        const double a = (double)ang;
        const double r = a - 6.283185307179586476925 * rint(a * 0.15915494309189533577);
        const float fr_ = (float)(r * 0.15915494309189533577);
        rope[i] = __builtin_amdgcn_cosf(fr_);
        rope[4096 * 16 + i] = __builtin_amdgcn_sinf(fr_);
    }
}

DEV void norm_phase(const float* __restrict__ x, const float* __restrict__ gain, bf16_t* __restrict__ h) {
    const int lane = TID & 63, wv = (BID * blockDim.x + TID) >> 6, nw = (gridDim.x * blockDim.x) >> 6;
    f32x4 g[4];
#pragma unroll
    for (int i = 0; i < 4; ++i) g[i] = *(const f32x4*)(gain + 4 * (lane + 64 * i));
    for (int row = wv; row < M_TOK; row += nw) {
        const float* xr = x + (size_t)row * DM;
        f32x4 v[4]; float ss = 0.f;
#pragma unroll
        for (int i = 0; i < 4; ++i) { v[i] = *(const f32x4*)(xr + 4 * (lane + 64 * i)); ss += v[i][0] * v[i][0] + v[i][1] * v[i][1] + v[i][2] * v[i][2] + v[i][3] * v[i][3]; }
#pragma unroll
        for (int o = 32; o > 0; o >>= 1) ss += __shfl_xor(ss, o);
        const float rstd = rsqrtf(ss * (1.0f / DM) + EPS);
        bf16_t* hr = h + (size_t)row * DM;
#pragma unroll
        for (int i = 0; i < 4; ++i) {
            u32x2 o; o.x = pk_bf16(v[i][0] * rstd * g[i][0], v[i][1] * rstd * g[i][1]); o.y = pk_bf16(v[i][2] * rstd * g[i][2], v[i][3] * rstd * g[i][3]);
            *(u32x2*)(hr + 4 * (lane + 64 * i)) = o;
        }
    }
}

enum { EPI_EVIN = 0, EPI_ODIN, EPI_QB, EPI_KVB, EPI_RESID, EPI_SWIGLU };
struct GemmP {
    const bf16_t* A; int lda; const bf16_t* Bt; int K; int nN; int epi;
    const float* xin; float* xout;
};

DEV void gemm_phase(const GemmP& g, char* smem, char* ws) {
    const int tid = TID, wid = tid >> 6, lane = tid & 63, fr = lane & 15, fq = lane >> 4;
    const int wp = wid >> 1, wq = wid & 1;
    const int nbx = gridDim.x >> 3, xcd = BID & 7, lb = BID >> 3;
    const int per_xcd = 32 * g.nN, grpsz = 8 * g.nN;
    const int K = g.K, lda = g.lda, nkt = K >> 6;
    const int lrow = tid >> 3, lchk = tid & 7;
    for (int t = lb; t < per_xcd; t += nbx) {
        const int grp = t / grpsz, r = t - grp * grpsz;
        const int tm = xcd * 32 + grp * 8 + (r & 7), tn = r >> 3;
        bool vt_tile = false; int vt_head = 0;
        if (g.epi == EPI_EVIN) { if (tn >= 16 && tn < 24) { vt_tile = true; vt_head = (tn - 16) * 2; } }
        else if (g.epi == EPI_ODIN) { if (tn >= 12) { vt_tile = true; vt_head = (tn - 12) * 2; } }
        else if (g.epi == EPI_KVB) { if (tn >= 4) { vt_tile = true; vt_head = 8 + (tn - 4) * 2; } }
        const bf16_t* Ag = g.A + (size_t)(tm * 128 + lrow) * lda + lchk * 8;
        const bf16_t* Wg = g.Bt + (size_t)(tn * 128 + lrow) * K + lchk * 8;
        u32x4 ra[4], rw[4];
        f32x4 acc[4][4];
#pragma unroll
        for (int i = 0; i < 4; ++i)
#pragma unroll
            for (int j = 0; j < 4; ++j) acc[i][j] = (f32x4){0.f, 0.f, 0.f, 0.f};
#pragma unroll
        for (int i = 0; i < 4; ++i) { ra[i] = *(const u32x4*)(Ag + (size_t)i * 32 * lda); rw[i] = *(const u32x4*)(Wg + (size_t)i * 32 * K); }
        __syncthreads();
#pragma unroll
        for (int i = 0; i < 4; ++i) {
            *(u32x4*)(smem + (lrow + 32 * i) * 144 + lchk * 16) = ra[i];
            *(u32x4*)(smem + 18432 + (lrow + 32 * i) * 144 + lchk * 16) = rw[i];
        }
        __syncthreads();
        for (int kt = 0; kt < nkt; ++kt) {
            const int buf = kt & 1;
            const bool more = kt + 1 < nkt;
            if (more) {
                const int k0 = (kt + 1) << 6;
#pragma unroll
                for (int i = 0; i < 4; ++i) { ra[i] = *(const u32x4*)(Ag + (size_t)i * 32 * lda + k0); rw[i] = *(const u32x4*)(Wg + (size_t)i * 32 * K + k0); }
            }
            const char* sX = smem + buf * 36864;
            const char* sW = sX + 18432;
            const char* pP = vt_tile ? sX : sW;
            const char* pQ = vt_tile ? sW : sX;
#pragma unroll
            for (int ks = 0; ks < 2; ++ks) {
                bf16x8 pf[4], qf[4];
#pragma unroll
                for (int i = 0; i < 4; ++i) {
                    pf[i] = *(const bf16x8*)(pP + (wp * 64 + i * 16 + fr) * 144 + (ks * 32 + fq * 8) * 2);
                    qf[i] = *(const bf16x8*)(pQ + (wq * 64 + i * 16 + fr) * 144 + (ks * 32 + fq * 8) * 2);
                }
#pragma unroll
                for (int pi = 0; pi < 4; ++pi)
#pragma unroll
                    for (int qi = 0; qi < 4; ++qi) acc[pi][qi] = __builtin_amdgcn_mfma_f32_16x16x32_bf16(pf[pi], qf[qi], acc[pi][qi], 0, 0, 0);
            }
            if (more) {
                char* dX = smem + (buf ^ 1) * 36864;
#pragma unroll
                for (int i = 0; i < 4; ++i) {
                    *(u32x4*)(dX + (lrow + 32 * i) * 144 + lchk * 16) = ra[i];
                    *(u32x4*)(dX + 18432 + (lrow + 32 * i) * 144 + lchk * 16) = rw[i];
                }
            }
            __syncthreads();
        }
        if (vt_tile) {
            bf16_t* VT = (bf16_t*)(ws + OFF_VT);
            const int b = tm >> 5, s0 = (tm & 31) * 128 + wp * 64 + fq * 4;
            const int head = vt_head + wq;
#pragma unroll
            for (int pi = 0; pi < 4; ++pi)
#pragma unroll
                for (int qi = 0; qi < 4; ++qi) {
                    const int d = qi * 16 + fr;
                    u32x2 o; o.x = pk_bf16(acc[pi][qi][0], acc[pi][qi][1]); o.y = pk_bf16(acc[pi][qi][2], acc[pi][qi][3]);
                    *(u32x2*)(VT + ((size_t)((b * 16 + head) * 64 + d)) * 4096 + s0 + pi * 16) = o;
                }
        } else {
            const int tok0 = tm * 128 + wq * 64 + fr;
            const int nb0 = tn * 128 + wp * 64 + fq * 4;
            if (g.epi == EPI_RESID) {
#pragma unroll
                for (int qi = 0; qi < 4; ++qi) {
                    const size_t ro = (size_t)(tok0 + qi * 16) * DM;
#pragma unroll
                    for (int pi = 0; pi < 4; ++pi) {
                        const f32x4 xi = *(const f32x4*)(g.xin + ro + nb0 + pi * 16);
                        *(f32x4*)(g.xout + ro + nb0 + pi * 16) = xi + acc[pi][qi];
                    }
                }
            } else if (g.epi == EPI_SWIGLU) {
                bf16_t* ACT = (bf16_t*)(ws + OFF_ACT);
#pragma unroll
                for (int qi = 0; qi < 4; ++qi) {
                    bf16_t* rp = ACT + (size_t)(tok0 + qi * 16) * DFF;
#pragma unroll
                    for (int pp = 0; pp < 2; ++pp) {
                        const f32x4 gv = acc[2 * pp][qi], uv = acc[2 * pp + 1][qi];
                        float o[4];
#pragma unroll
                        for (int j = 0; j < 4; ++j) o[j] = gv[j] / (1.0f + __expf(-gv[j])) * uv[j];
                        u32x2 w; w.x = pk_bf16(o[0], o[1]); w.y = pk_bf16(o[2], o[3]);
                        *(u32x2*)(rp + 16 * (tn * 4 + wp * 2 + pp) + fq * 4) = w;
                    }
                }
            } else if (g.epi == EPI_EVIN && tn == 24) {
                if (wp == 0 && fq < 2) {
                    float* FA = (float*)(ws + OFF_FA);
#pragma unroll
                    for (int qi = 0; qi < 4; ++qi) *(f32x4*)(FA + (size_t)(tok0 + qi * 16) * 8 + fq * 4) = acc[0][qi];
                }
            } else {
                bf16_t* C; int ldc;
                if (g.epi == EPI_EVIN) { C = (bf16_t*)(ws + OFF_EB); ldc = 2048; }
                else if (g.epi == EPI_ODIN) { C = (bf16_t*)(ws + OFF_EB); ldc = 1536; }
                else if (g.epi == EPI_QB) { C = (bf16_t*)(ws + OFF_QD); ldc = 768; }
                else { C = (bf16_t*)(ws + OFF_KD); ldc = 768; }
#pragma unroll
                for (int qi = 0; qi < 4; ++qi) {
                    bf16_t* rp = C + (size_t)(tok0 + qi * 16) * ldc;
#pragma unroll
                    for (int pi = 0; pi < 4; ++pi) {
                        int col = nb0 + pi * 16;
                        if (g.epi == EPI_KVB) col = (col >> 6) * 96 + (col & 63);
                        u32x2 o; o.x = pk_bf16(acc[pi][qi][0], acc[pi][qi][1]); o.y = pk_bf16(acc[pi][qi][2], acc[pi][qi][3]);
                        *(u32x2*)(rp + col) = o;
                    }
                }
            }
        }
    }
}

template <int LPR, bool MEAN>
DEV void rownorm_block(bf16_t* buf, int ld, int col0, const float* __restrict__ gain, int row0, float* kmean_out, float* red) {
    constexpr int RPI = 256 / LPR;
    const int tid = TID, sub = tid % LPR, rr = tid / LPR;
    float g[8], am[8];
#pragma unroll
    for (int i = 0; i < 8; ++i) { g[i] = gain[sub * 8 + i]; am[i] = 0.f; }
    for (int it = 0; it < 256 / RPI; ++it) {
        bf16_t* rp = buf + (size_t)(row0 + it * RPI + rr) * ld + col0 + sub * 8;
        const u32x4 v = *(const u32x4*)rp;
        float x[8] = {bf_lo(v.x), bf_hi(v.x), bf_lo(v.y), bf_hi(v.y), bf_lo(v.z), bf_hi(v.z), bf_lo(v.w), bf_hi(v.w)};
        float ss = 0.f;
#pragma unroll
        for (int i = 0; i < 8; ++i) ss += x[i] * x[i];
#pragma unroll
        for (int o = 1; o < LPR; o <<= 1) ss += __shfl_xor(ss, o);
        const float rstd = rsqrtf(ss * (1.0f / (LPR * 8)) + EPS);
#pragma unroll
        for (int i = 0; i < 8; ++i) { x[i] = x[i] * rstd * g[i]; if (MEAN) am[i] += x[i]; }
        u32x4 o; o.x = pk_bf16(x[0], x[1]); o.y = pk_bf16(x[2], x[3]); o.z = pk_bf16(x[4], x[5]); o.w = pk_bf16(x[6], x[7]);
        *(u32x4*)rp = o;
    }
    if (MEAN) {
        __syncthreads();
#pragma unroll
        for (int i = 0; i < 8; ++i) red[rr * 64 + sub * 8 + i] = am[i];
        __syncthreads();
        if (tid < 64) {
            float s = 0.f;
            for (int r = 0; r < RPI; ++r) s += red[r * 64 + tid];
            kmean_out[tid] = s * (1.0f / 256.0f);
        }
    }
}

DEV void even_post(const Params& p, int li, char* smem) {
    char* ws = p.ws;
    bf16_t* EB = (bf16_t*)(ws + OFF_EB);
    float* red = (float*)smem;
    for (int it = BID; it < 2048 + 64; it += gridDim.x) {
        if (it < 2048) {
            const int blk = it >> 4, hh = it & 15;
            rownorm_block<8, false>(EB, 2048, hh * 64, (hh < 8 ? p.ev_qn : p.ev_kn) + li * 64, blk * 256, nullptr, red);
        } else {
            const int bh = it - 2048, b = bh >> 3, h = bh & 7, tid = TID, lane = tid & 63, wid = tid >> 6;
            const float* FA = (const float*)(ws + OFF_FA);
            float* CD = (float*)(ws + OFF_CDEC) + (size_t)bh * 4096;
            const float fb = p.ev_fb[li * 8 + h];
            float lf[16]; float run = 0.f;
#pragma unroll
            for (int i = 0; i < 16; ++i) {
                const float z = FA[(size_t)(b * 4096 + tid * 16 + i) * 8 + h] + fb;
                const float ls = fminf(z, 0.f) - log1pf(expf(-fabsf(z)));
                run += ls; lf[i] = run;
            }
            float inc = run;
#pragma unroll
            for (int o = 1; o < 64; o <<= 1) { const float y = __shfl_up(inc, o); if (lane >= o) inc += y; }
            __syncthreads();
            if (lane == 63) red[wid] = inc;
            __syncthreads();
            float base = inc - run;
            for (int w = 0; w < wid; ++w) base += red[w];
#pragma unroll
            for (int i = 0; i < 16; ++i) CD[tid * 16 + i] = (base + lf[i]) * LOG2E;
            __syncthreads();
        }
    }
}

DEV void odd_post1(const Params& p, int li, char* smem) {
    char* ws = p.ws;
    bf16_t* OB = (bf16_t*)(ws + OFF_EB);
    float* red = (float*)smem;
    float* KM = (float*)(ws + OFF_KMEAN);
    for (int it = BID; it < 2304; it += gridDim.x) {
        if (it < 1024) {
            const int blk = it >> 3, h = it & 7, b = blk >> 4, nb = blk & 15;
            rownorm_block<8, true>(OB, 1536, 512 + h * 64, p.od_mkn + li * 64, blk * 256, KM + (size_t)((b * 8 + h) * 16 + nb) * 64, red);
            __syncthreads();
        } else if (it < 2048) {
            const int j = it - 1024, blk = j >> 3, h = j & 7;
            rownorm_block<8, false>(OB, 1536, h * 64, p.od_mqn + li * 64, blk * 256, nullptr, red);
        } else if (it < 2176) {
            rownorm_block<32, false>(OB, 1536, 1024, p.od_qan + li * 256, (it - 2048) * 256, nullptr, red);
        } else {
            rownorm_block<16, false>(OB, 1536, 1280, p.od_kvan + li * 128, (it - 2176) * 256, nullptr, red);
        }
    }
}

DEV void moba_gate(const Params& p) {
    char* ws = p.ws;
    const bf16_t* OB = (const bf16_t*)(ws + OFF_EB);
    const float* KM = (const float*)(ws + OFF_KMEAN);
    int* SEL = (int*)(ws + OFF_SEL);
    const int gt = BID * blockDim.x + TID, gn = gridDim.x * blockDim.x;
    for (int w = gt; w < 8 * M_TOK; w += gn) {
        const int h = w >> 15, token = w & (M_TOK - 1), b = token >> 12, s = token & 4095, cur = s >> 8;
        float q[64];
        const u32x4* qp = (const u32x4*)(OB + (size_t)token * 1536 + h * 64);
#pragma unroll
        for (int i = 0; i < 8; ++i) { const u32x4 v = qp[i]; q[8 * i] = bf_lo(v.x); q[8 * i + 1] = bf_hi(v.x); q[8 * i + 2] = bf_lo(v.y); q[8 * i + 3] = bf_hi(v.y);
            q[8 * i + 4] = bf_lo(v.z); q[8 * i + 5] = bf_hi(v.z); q[8 * i + 6] = bf_lo(v.w); q[8 * i + 7] = bf_hi(v.w); }
        float v1 = -INFINITY, v2 = -INFINITY, v3 = -INFINITY; int i1 = -1, i2 = -1, i3 = -1;
        const float* kmb = KM + (size_t)((b * 8 + h) * 16) * 64;
        for (int n = 0; n < cur; ++n) {
            const f32x4* km = (const f32x4*)(kmb + n * 64);
            float d = 0.f;
#pragma unroll
            for (int i = 0; i < 16; ++i) { const f32x4 k4 = km[i]; d += q[4 * i] * k4[0] + q[4 * i + 1] * k4[1] + q[4 * i + 2] * k4[2] + q[4 * i + 3] * k4[3]; }
            if (d > v1) { v3 = v2; i3 = i2; v2 = v1; i2 = i1; v1 = d; i1 = n; }
            else if (d > v2) { v3 = v2; i3 = i2; v2 = d; i2 = n; }
            else if (d > v3) { v3 = d; i3 = n; }
        }
        int m = 0;
        if (i1 >= 0) m |= 1 << i1;
        if (i2 >= 0) m |= 1 << i2;
        if (i3 >= 0) m |= 1 << i3;
        SEL[(size_t)(b * 8 + h) * 4096 + s] = m;
    }
}

DEV void mla_post(const Params& p, int li) {
    char* ws = p.ws;
    bf16_t* QD = (bf16_t*)(ws + OFF_QD);
    bf16_t* KD = (bf16_t*)(ws + OFF_KD);
    const bf16_t* OB = (const bf16_t*)(ws + OFF_EB);
    const float* rope = (const float*)(ws + OFF_ROPE);
    const int gt = BID * blockDim.x + TID, gn = gridDim.x * blockDim.x;
    for (int w = gt; w < 2 * 8 * M_TOK; w += gn) {
        const int isk = w >> 18, rem = w & ((1 << 18) - 1), token = rem >> 3, h = rem & 7, s = token & 4095;
        bf16_t* rp = (isk ? KD : QD) + (size_t)token * 768 + h * 96;
        const float* gain = (isk ? p.od_lkn : p.od_lqn) + li * 96;
        float x[96];
#pragma unroll
        for (int i = 0; i < 12; ++i) {
            u32x4 v;
            if (isk && i >= 8) v = *(const u32x4*)(OB + (size_t)token * 1536 + 1408 + (i - 8) * 8);
            else v = *(const u32x4*)(rp + i * 8);
            x[8 * i] = bf_lo(v.x); x[8 * i + 1] = bf_hi(v.x); x[8 * i + 2] = bf_lo(v.y); x[8 * i + 3] = bf_hi(v.y);
            x[8 * i + 4] = bf_lo(v.z); x[8 * i + 5] = bf_hi(v.z); x[8 * i + 6] = bf_lo(v.w); x[8 * i + 7] = bf_hi(v.w);
        }
        float ss = 0.f;
#pragma unroll
        for (int i = 0; i < 96; ++i) ss += x[i] * x[i];
        const float rstd = rsqrtf(ss * (1.0f / 96.0f) + EPS);
#pragma unroll
        for (int i = 0; i < 96; ++i) x[i] = x[i] * rstd * gain[i];
        const float* cs = rope + (size_t)s * 16;
        const float* sn = rope + 4096 * 16 + (size_t)s * 16;
#pragma unroll
        for (int i = 0; i < 16; ++i) {
            const float c = cs[i], sv = sn[i], a = x[64 + i], bb = x[80 + i];
            x[64 + i] = a * c - bb * sv; x[80 + i] = a * sv + bb * c;
        }
#pragma unroll
        for (int i = 0; i < 12; ++i) {
            u32x4 o; o.x = pk_bf16(x[8 * i], x[8 * i + 1]); o.y = pk_bf16(x[8 * i + 2], x[8 * i + 3]); o.z = pk_bf16(x[8 * i + 4], x[8 * i + 5]); o.w = pk_bf16(x[8 * i + 6], x[8 * i + 7]);
            *(u32x4*)(rp + i * 8) = o;
        }
    }
}

enum { AT_FOX = 0, AT_SB, AT_MOBA, AT_MLA };
constexpr int AT_KBUF = 13312, AT_VBUF = 8192, AT_K0 = 0, AT_V0 = 2 * AT_KBUF, AT_MISC = AT_V0 + 2 * AT_VBUF, AT_CK = AT_MISC + 1024;

template <int MODE>
DEV void attn_item(const Params& p, char* smem, int b, int h, int qt) {
    constexpr int DQK = (MODE == AT_MLA) ? 96 : 64;
    constexpr int NKS = DQK / 32;
    constexpr int KSTRB = (DQK + 8) * 2;
    constexpr int KCH = DQK / 8;
    constexpr int KLD = (64 * KCH) / 256;
    char* ws = p.ws;
    const int tid = TID, wid = tid >> 6, lane = tid & 63, fr = lane & 15, fq = lane >> 4;
    const bf16_t* Qb; const bf16_t* Kb; int ldq; int head16;
    if (MODE == AT_FOX) { Qb = (const bf16_t*)(ws + OFF_EB) + h * 64; Kb = Qb + 512; ldq = 2048; head16 = h; }
    else if (MODE == AT_SB) { Qb = (const bf16_t*)(ws + OFF_EB) + 1024 + h * 64; Kb = Qb + 512; ldq = 2048; head16 = 8 + h; }
    else if (MODE == AT_MOBA) { Qb = (const bf16_t*)(ws + OFF_EB) + h * 64; Kb = Qb + 512; ldq = 1536; head16 = h; }
    else { Qb = (const bf16_t*)(ws + OFF_QD) + h * 96; Kb = (const bf16_t*)(ws + OFF_KD) + h * 96; ldq = 768; head16 = 8 + h; }
    const bf16_t* Vt = (const bf16_t*)(ws + OFF_VT) + (size_t)((b * 16 + head16) * 64) * 4096;
    const size_t tokb = (size_t)b * 4096;
    const int qpos = qt * 64 + wid * 16 + fr;
    int* smi = (int*)(smem + AT_MISC);
    float* btab = (float*)(smem + AT_MISC + 512);

    __syncthreads();
    int mysel = 0;
    if (MODE == AT_MOBA) {
        mysel = ((const int*)(ws + OFF_SEL))[(size_t)(b * 8 + h) * 4096 + qpos];
        if (tid == 0) smi[73] = 0;
        if (tid < 128) btab[tid] = ((const float*)(ws + OFF_BTAB))[h * 128 + tid];
        __syncthreads();
        if (fq == 0) atomicOr(&smi[73], mysel);
        __syncthreads();
    }
    if (tid == 0) {
        int n = 0;
        if (MODE == AT_FOX || MODE == AT_MLA) { for (int t = 0; t <= qt; ++t) smi[n++] = t; }
        else if (MODE == AT_SB) { for (int t = qt; t >= 0; --t) smi[n++] = t; }
        else {
            const int cur = qt >> 2, um = smi[73];
            for (int t = cur * 4; t <= qt; ++t) smi[n++] = t;
            for (int kb = 0; kb < cur; ++kb) if ((um >> kb) & 1) { for (int t = 0; t < 4; ++t) smi[n++] = kb * 4 + t; }
        }
        smi[72] = n;
    }
    __syncthreads();
    const int nt = smi[72];

    bf16x8 qf[NKS];
    {
        const bf16_t* qp = Qb + (tokb + qpos) * ldq + fq * 8;
#pragma unroll
        for (int ks = 0; ks < NKS; ++ks) qf[ks] = *(const bf16x8*)(qp + ks * 32);
    }
    float cq = 0.f;
    const float* CD = (const float*)(ws + OFF_CDEC) + (size_t)(b * 8 + h) * 4096;
    if (MODE == AT_FOX) cq = CD[qpos];
    const float c1 = (MODE == AT_MLA ? 0.10206207261596577f : 0.125f) * (MODE == AT_SB ? 1.0f : LOG2E);

    f32x4 o[4];
#pragma unroll
    for (int i = 0; i < 4; ++i) o[i] = (f32x4){0.f, 0.f, 0.f, 0.f};
    float mrun = -1e30f, lsum = 0.f, R = 0.f;

    u32x4 rk[KLD], rv[2]; f32x4 rc = (f32x4){0.f, 0.f, 0.f, 0.f};
    auto gload = [&](int tile) {
        if (MODE == AT_FOX) { if (tid < 16) rc = *(const f32x4*)(CD + tile * 64 + tid * 4); }
#pragma unroll
        for (int i = 0; i < KLD; ++i) { const int idx = tid + 256 * i, r = idx / KCH, c = idx % KCH; rk[i] = *(const u32x4*)(Kb + (tokb + tile * 64 + r) * ldq + c * 8); }
#pragma unroll
        for (int i = 0; i < 2; ++i) { const int idx = tid + 256 * i, d = idx >> 3, c8 = idx & 7; rv[i] = *(const u32x4*)(Vt + (size_t)d * 4096 + tile * 64 + c8 * 8); }
    };
    auto lstore = [&](int buf) {
        char* kb = smem + AT_K0 + buf * AT_KBUF; char* vb = smem + AT_V0 + buf * AT_VBUF;
        if (MODE == AT_FOX) { if (tid < 16) *(f32x4*)(smem + AT_CK + buf * 256 + tid * 16) = rc; }
#pragma unroll
        for (int i = 0; i < KLD; ++i) { const int idx = tid + 256 * i, r = idx / KCH, c = idx % KCH; *(u32x4*)(kb + r * KSTRB + c * 16) = rk[i]; }
#pragma unroll
        for (int i = 0; i < 2; ++i) { const int idx = tid + 256 * i, d = idx >> 3, c8 = idx & 7; *(u32x4*)(vb + ((c8 >> 1) * 64 + d) * 32 + (c8 & 1) * 16) = rv[i]; }
    };
    gload(smi[0]); lstore(0);
    __syncthreads();
    for (int it = 0; it < nt; ++it) {
        const int tile = smi[it], buf = it & 1;
        const bool more = it + 1 < nt;
        if (more) gload(smi[it + 1]);
        const char* kb = smem + AT_K0 + buf * AT_KBUF; const char* vb = smem + AT_V0 + buf * AT_VBUF;
        f32x4 s[4];
#pragma unroll
        for (int kt = 0; kt < 4; ++kt) {
            s[kt] = (f32x4){0.f, 0.f, 0.f, 0.f};
#pragma unroll
            for (int ks = 0; ks < NKS; ++ks) {
                const bf16x8 kf = *(const bf16x8*)(kb + (kt * 16 + fr) * KSTRB + (ks * 32 + fq * 8) * 2);
                s[kt] = __builtin_amdgcn_mfma_f32_16x16x32_bf16(kf, qf[ks], s[kt], 0, 0, 0);
            }
        }
        const int kbase = tile * 64 + fq * 4;
        const bool diag = (tile == qt);
        const bool far_tile = (MODE == AT_MOBA) && (qt * 64 - (tile * 64 + 63) >= 127);
        const float bfar = (MODE == AT_MOBA) ? btab[127] : 0.f;
        unsigned pp[4][2];
        if (MODE == AT_SB) {
            float T[4], exq[4], ls[4][4], e[4][4];
#pragma unroll
            for (int kt = 0; kt < 4; ++kt) {
                float v[4];
#pragma unroll
                for (int j = 0; j < 4; ++j) {
                    const float z = s[kt][j] * c1;
                    const float sp = __logf(1.0f + __expf(-fabsf(z)));
                    const float l = fminf(z, 0.f) - sp;
                    const bool strict = !diag || (kbase + kt * 16 + j < qpos);
                    ls[kt][j] = strict ? l : -INFINITY;
                    v[j] = strict ? (l - z) : 0.f;
                }
                e[kt][3] = 0.f; e[kt][2] = v[3]; e[kt][1] = v[3] + v[2]; e[kt][0] = e[kt][1] + v[1];
                const float G = e[kt][0] + v[0];
#if DBG_NOSHFL
                exq[kt] = 0.f; T[kt] = G;
#else
                float xs = G;
                float y = __shfl_down(xs, 16); if (fq < 3) xs += y;
                y = __shfl_down(xs, 32); if (fq < 2) xs += y;
                exq[kt] = xs - G;
                T[kt] = __shfl(xs, fr);
#endif
            }
            float off = R;
#pragma unroll
            for (int kt = 3; kt >= 0; --kt) {
                float w[4];
#pragma unroll
                for (int j = 0; j < 4; ++j) w[j] = __expf(ls[kt][j] + off + exq[kt] + e[kt][j]);
                pp[kt][0] = pk_bf16(w[0], w[1]); pp[kt][1] = pk_bf16(w[2], w[3]);
                off += T[kt];
            }
            R = off;
        } else {
            float t[4][4];
            float mx = -1e30f;
#pragma unroll
            for (int kt = 0; kt < 4; ++kt) {
                f32x4 bias = (f32x4){0.f, 0.f, 0.f, 0.f};
                if (MODE == AT_FOX) { const f32x4 ck = *(const f32x4*)(smem + AT_CK + buf * 256 + (kt * 16 + fq * 4) * 4); bias = (f32x4){cq, cq, cq, cq} - ck; }
                bool blk_ok = true;
                if (MODE == AT_MOBA) {
                    blk_ok = (tile >> 2) == (qt >> 2) || ((mysel >> (tile >> 2)) & 1);
                    if (far_tile) { bias = (f32x4){bfar, bfar, bfar, bfar}; }
                    else {
#pragma unroll
                        for (int j = 0; j < 4; ++j) { int dist = qpos - (kbase + kt * 16 + j); dist = dist < 0 ? 0 : (dist > 127 ? 127 : dist); bias[j] = btab[dist]; }
                    }
                }
#pragma unroll
                for (int j = 0; j < 4; ++j) {
                    float v = s[kt][j] * c1 + bias[j];
                    const bool ok = blk_ok && (!diag || (kbase + kt * 16 + j <= qpos));
                    v = ok ? v : -1e30f;
                    t[kt][j] = v; mx = fmaxf(mx, v);
                }
            }
            mx = fmaxf(mx, __shfl_xor(mx, 16)); mx = fmaxf(mx, __shfl_xor(mx, 32));
            const float mnew = fmaxf(mrun, mx);
            const float alpha = __builtin_amdgcn_exp2f(mrun - mnew);
            mrun = mnew;
            float ps = 0.f;
#pragma unroll
            for (int kt = 0; kt < 4; ++kt) {
                float w[4];
#pragma unroll
                for (int j = 0; j < 4; ++j) { w[j] = __builtin_amdgcn_exp2f(t[kt][j] - mnew); ps += w[j]; }
                pp[kt][0] = pk_bf16(w[0], w[1]); pp[kt][1] = pk_bf16(w[2], w[3]);
            }
            lsum = lsum * alpha + ps;
#pragma unroll
            for (int i = 0; i < 4; ++i) o[i] = o[i] * alpha;
        }
#pragma unroll
        for (int kk = 0; kk < 2; ++kk) {
            u32x4 pw; pw.x = pp[2 * kk][0]; pw.y = pp[2 * kk][1]; pw.z = pp[2 * kk + 1][0]; pw.w = pp[2 * kk + 1][1];
            const bf16x8 pf = __builtin_bit_cast(bf16x8, pw);
#pragma unroll
            for (int dt = 0; dt < 4; ++dt) {
                const u32x2 lo = *(const u32x2*)(vb + ((2 * kk) * 64 + dt * 16 + fr) * 32 + fq * 8);
                const u32x2 hi = *(const u32x2*)(vb + ((2 * kk + 1) * 64 + dt * 16 + fr) * 32 + fq * 8);
                u32x4 vw; vw.x = lo.x; vw.y = lo.y; vw.z = hi.x; vw.w = hi.y;
                o[dt] = __builtin_amdgcn_mfma_f32_16x16x32_bf16(__builtin_bit_cast(bf16x8, vw), pf, o[dt], 0, 0, 0);
            }
        }
        if (more) lstore(buf ^ 1);
        if (MODE == AT_SB && !NO_SB_EXIT) {
            if (__syncthreads_and(R < -40.0f)) break;
        } else {
            __syncthreads();
        }
    }
    float inv = 1.0f;
    if (MODE != AT_SB) {
        float l = lsum; l += __shfl_xor(l, 16); l += __shfl_xor(l, 32);
        inv = 1.0f / l;
    }
    bf16_t* op = (bf16_t*)(ws + OFF_HM) + (tokb + qpos) * 1024 + head16 * 64 + fq * 4;
#pragma unroll
    for (int dt = 0; dt < 4; ++dt) {
        float q0 = o[dt][0] * inv, q1 = o[dt][1] * inv, q2 = o[dt][2] * inv, q3 = o[dt][3] * inv;
        if (!(fabsf(q0) < 1e30f)) q0 = 777.f; if (!(fabsf(q1) < 1e30f)) q1 = 777.f; if (!(fabsf(q2) < 1e30f)) q2 = 777.f; if (!(fabsf(q3) < 1e30f)) q3 = 777.f;
        u32x2 w; w.x = pk_bf16(q0, q1); w.y = pk_bf16(q2, q3);
        *(u32x2*)(op + dt * 16) = w;
    }
}

DEV void attn_phase(const Params& p, char* smem, bool even, unsigned* ctr) {
    int* smi = (int*)(smem + AT_MISC);
    const int tid = TID;
    for (;;) {
        __syncthreads();
        if (tid == 0) smi[74] = (int)__hip_atomic_fetch_add(ctr, 1u, __ATOMIC_RELAXED, __HIP_MEMORY_SCOPE_AGENT);
        __syncthreads();
        const int it = smi[74];
        if (it >= 64 * 128) break;
        const int qt = 63 - (it >> 7), bh = it & 127, b = bh >> 4, h16 = bh & 15;
        if (even) { if (h16 < 8) attn_item<AT_FOX>(p, smem, b, h16, qt); else attn_item<AT_SB>(p, smem, b, h16 - 8, qt); }
        else { if (h16 < 8) attn_item<AT_MOBA>(p, smem, b, h16, qt); else attn_item<AT_MLA>(p, smem, b, h16 - 8, qt); }
    }
}

DEV void gsync(unsigned* ctr, unsigned& target) {
    __builtin_amdgcn_fence(__ATOMIC_RELEASE, "agent");
    __syncthreads();
    target += gridDim.x;
    if (threadIdx.x == 0) {
        __hip_atomic_fetch_add(ctr, 1u, __ATOMIC_RELEASE, __HIP_MEMORY_SCOPE_AGENT);
        while (__hip_atomic_load(ctr, __ATOMIC_ACQUIRE, __HIP_MEMORY_SCOPE_AGENT) < target) __builtin_amdgcn_s_sleep(4);
    }
    __syncthreads();
    __builtin_amdgcn_fence(__ATOMIC_ACQUIRE, "agent");
}

enum { OP_NORM_MIX = 0, OP_GEMM_IN, OP_EPOST, OP_OPOST1, OP_GEMM_QB, OP_GEMM_KVB, OP_GATE, OP_MLAPOST, OP_ATTN, OP_GEMM_OUT, OP_NORM_FFN, OP_GEMM_GU, OP_GEMM_DN };

__global__ void __launch_bounds__(256, 2) fwd_megakernel(Params p) {
    extern __shared__ __attribute__((aligned(16))) char smem[];
    cg::grid_group grid = cg::this_grid();
    char* ws = p.ws;
    unsigned* bar = (unsigned*)(ws + OFF_BAR);
    unsigned btarget = 0;
    grid.sync();
    prologue(p, smem);
    gsync(bar, btarget);
    int gstep = 0;
    for (int layer = 0; layer < 4; ++layer) {
        const int li = layer >> 1;
        const bool even = (layer & 1) == 0;
        const float* xin = layer == 0 ? p.x : p.out;
        const int nsteps = even ? 8 : 12;
        for (int step = 0; step < nsteps; ++step) {
#ifdef DBG_STEPS
            if (gstep >= DBG_STEPS) break;
#endif
            ++gstep;
            int op; bool sync = true;
            if (even) {
                switch (step) { case 0: op = OP_NORM_MIX; break; case 1: op = OP_GEMM_IN; break; case 2: op = OP_EPOST; break; case 3: op = OP_ATTN; break;
                                case 4: op = OP_GEMM_OUT; break; case 5: op = OP_NORM_FFN; break; case 6: op = OP_GEMM_GU; break; default: op = OP_GEMM_DN; break; }
            } else {
                switch (step) { case 0: op = OP_NORM_MIX; break; case 1: op = OP_GEMM_IN; break; case 2: op = OP_OPOST1; break; case 3: op = OP_GEMM_QB; break;
                                case 4: op = OP_GEMM_KVB; break; case 5: op = OP_GATE; break; case 6: op = OP_MLAPOST; break; case 7: op = OP_ATTN; break;
                                case 8: op = OP_GEMM_OUT; break; case 9: op = OP_NORM_FFN; break; case 10: op = OP_GEMM_GU; break; default: op = OP_GEMM_DN; break; }
            }
            if (op == OP_GEMM_QB || op == OP_GEMM_KVB) sync = false;
            switch (op) {
            case OP_NORM_MIX: norm_phase(xin, (even ? p.ev_norm : p.od_norm) + li * DM, (bf16_t*)(ws + OFF_HM)); break;
            case OP_NORM_FFN: norm_phase(p.out, p.ffn_norm + layer * DM, (bf16_t*)(ws + OFF_HM)); break;
            case OP_EPOST: even_post(p, li, smem); break;
            case OP_OPOST1: odd_post1(p, li, smem); break;
            case OP_GATE: moba_gate(p); break;
            case OP_MLAPOST: mla_post(p, li); break;
            case OP_ATTN: attn_phase(p, smem, even, bar + 16 + layer); break;
            default: {
                GemmP g; g.xin = nullptr; g.xout = nullptr;
                if (op == OP_GEMM_IN) {
                    g.A = (const bf16_t*)(ws + OFF_HM); g.lda = 1024; g.K = 1024;
                    if (even) { g.Bt = (const bf16_t*)(ws + OFF_EVIN) + li * SZ_EVIN; g.nN = 25; g.epi = EPI_EVIN; }
                    else { g.Bt = (const bf16_t*)(ws + OFF_ODIN) + li * SZ_ODIN; g.nN = 16; g.epi = EPI_ODIN; }
                } else if (op == OP_GEMM_QB) {
                    g.A = (const bf16_t*)(ws + OFF_EB) + 1024; g.lda = 1536; g.K = 256; g.Bt = (const bf16_t*)(ws + OFF_QB) + li * SZ_QB; g.nN = 6; g.epi = EPI_QB;
                } else if (op == OP_GEMM_KVB) {
                    g.A = (const bf16_t*)(ws + OFF_EB) + 1280; g.lda = 1536; g.K = 128; g.Bt = (const bf16_t*)(ws + OFF_KVB) + li * SZ_KVB; g.nN = 8; g.epi = EPI_KVB;
                } else if (op == OP_GEMM_OUT) {
                    g.A = (const bf16_t*)(ws + OFF_HM); g.lda = 1024; g.K = 1024; g.Bt = (const bf16_t*)(ws + (even ? OFF_EVOUT : OFF_ODOUT)) + li * SZ_OUT; g.nN = 8; g.epi = EPI_RESID;
                    g.xin = xin; g.xout = p.out;
                } else if (op == OP_GEMM_GU) {
                    g.A = (const bf16_t*)(ws + OFF_HM); g.lda = 1024; g.K = 1024; g.Bt = (const bf16_t*)(ws + OFF_GU) + layer * SZ_GU; g.nN = 44; g.epi = EPI_SWIGLU;
                } else {
                    g.A = (const bf16_t*)(ws + OFF_ACT); g.lda = DFF; g.K = DFF; g.Bt = (const bf16_t*)(ws + OFF_DN) + layer * SZ_DN; g.nN = 8; g.epi = EPI_RESID;
                    g.xin = p.out; g.xout = p.out;
                }
                gemm_phase(g, smem, ws);
            } break;
            }
            if (sync) gsync(bar, btarget);
        }
    }
#ifdef DBG_STEPS
    gsync(bar, btarget);
    {
        const size_t n = (size_t)M_TOK * 1024;
        const bf16_t* b0 = (const bf16_t*)(ws + OFF_HM);
        const bf16_t* b1 = (const bf16_t*)(ws + DBG_OFF1);
        const bf16_t* b2 = (const bf16_t*)(ws + DBG_OFF2);
        const bf16_t* b3 = (const bf16_t*)(ws + OFF_EB + (size_t)M_TOK * 1024 * 2);
        for (size_t i = (size_t)blockIdx.x * 256 + threadIdx.x; i < n; i += (size_t)gridDim.x * 256) {
            float v = bf_lo(b0[i]) + bf_lo(b1[i]) + bf_lo(b2[i]) + bf_lo(b3[i]);
            if (DBG_STEPS >= 5) v += p.out[i];
            p.out[i] = v;
        }
    }
#endif
}

extern "C" void kernel_launch(void* const* d_in, const int* in_sizes, int n_in, void* d_out, int out_size, void* d_ws, size_t ws_size,
                              hipStream_t stream) {
    if (ws_size < OFF_END + 256) return;
    static int grid_blocks = 0;
    if (!grid_blocks) {
        int dev = 0, cus = 0, per_cu = 0;
        hipGetDevice(&dev);
        hipDeviceGetAttribute(&cus, hipDeviceAttributeMultiprocessorCount, dev);
        hipFuncSetAttribute((const void*)fwd_megakernel, hipFuncAttributeMaxDynamicSharedMemorySize, SMEM_BYTES);
        hipOccupancyMaxActiveBlocksPerMultiprocessor(&per_cu, fwd_megakernel, 256, SMEM_BYTES);
        if (per_cu > 2) per_cu = 2;
        if (per_cu < 1) per_cu = 1;
        grid_blocks = cus * per_cu;
    }
    Params p{};
    p.x = (const float*)d_in[0]; p.ffn_norm = (const float*)d_in[1]; p.w_gu = (const float*)d_in[2]; p.w_dn = (const float*)d_in[3];
    p.rel_bias = (const float*)d_in[4]; p.ev_norm = (const float*)d_in[5]; p.ev_w_in = (const float*)d_in[6]; p.ev_fb = (const float*)d_in[7];
    p.ev_qn = (const float*)d_in[8]; p.ev_kn = (const float*)d_in[9]; p.ev_w_out = (const float*)d_in[10]; p.od_norm = (const float*)d_in[11];
    p.od_w_in = (const float*)d_in[12]; p.od_mqn = (const float*)d_in[13]; p.od_mkn = (const float*)d_in[14]; p.od_qan = (const float*)d_in[15];
    p.od_wqb = (const float*)d_in[16]; p.od_kvan = (const float*)d_in[17]; p.od_wkvb = (const float*)d_in[18]; p.od_lqn = (const float*)d_in[19];
    p.od_lkn = (const float*)d_in[20]; p.od_w_out = (const float*)d_in[21];
    p.out = (float*)d_out; p.ws = (char*)d_ws;
    hipMemsetAsync((char*)d_ws + OFF_BAR, 0, 256, stream);
    void* args[] = {&p};
    hipError_t e = hipLaunchCooperativeKernel((void*)fwd_megakernel, dim3(grid_blocks), dim3(256), args, SMEM_BYTES, stream);
    if (e != hipSuccess) fprintf(stderr, "cooperative launch failed: %s (grid %d)\n", hipGetErrorString(e), grid_blocks);
}

#ifdef PHASE_TEST
__global__ void __launch_bounds__(256, 2) t_prologue(Params p) { extern __shared__ __attribute__((aligned(16))) char smem[]; prologue(p, smem); }
__global__ void __launch_bounds__(256, 2) t_norm(Params p) { norm_phase(p.x, p.ev_norm, (bf16_t*)p.ws); }
__global__ void __launch_bounds__(256, 2) t_gemm(Params p, GemmP g) { extern __shared__ __attribute__((aligned(16))) char smem[]; gemm_phase(g, smem, p.ws); }
__global__ void __launch_bounds__(256, 2) t_epost(Params p) { extern __shared__ __attribute__((aligned(16))) char smem[]; even_post(p, 0, smem); }
__global__ void __launch_bounds__(256, 2) t_opost(Params p) { extern __shared__ __attribute__((aligned(16))) char smem[]; odd_post1(p, 0, smem); }
__global__ void __launch_bounds__(256, 2) t_gate(Params p) { moba_gate(p); }
__global__ void __launch_bounds__(256, 2) t_mlapost(Params p) { mla_post(p, 0); }
__global__ void __launch_bounds__(256, 2) t_attn_fox(Params p) { extern __shared__ __attribute__((aligned(16))) char smem[]; attn_item<AT_FOX>(p, smem, 0, 0, blockIdx.x); }
__global__ void __launch_bounds__(256, 2) t_attn_sb(Params p) { extern __shared__ __attribute__((aligned(16))) char smem[]; attn_item<AT_SB>(p, smem, 0, 0, blockIdx.x); }
__global__ void __launch_bounds__(256, 2) t_attn_moba(Params p) { extern __shared__ __attribute__((aligned(16))) char smem[]; attn_item<AT_MOBA>(p, smem, 0, 0, blockIdx.x); }
__global__ void __launch_bounds__(256, 2) t_attn_mla(Params p) { extern __shared__ __attribute__((aligned(16))) char smem[]; attn_item<AT_MLA>(p, smem, 0, 0, blockIdx.x); }
#endif
```

```cpp
#include <hip/hip_runtime.h>
#include <hip/hip_cooperative_groups.h>
#include <cstdio>
#include <cstdint>
namespace cg = cooperative_groups;

typedef unsigned short bf16_t;
typedef short bf16x8 __attribute__((ext_vector_type(8)));
typedef float f32x4 __attribute__((ext_vector_type(4)));
typedef unsigned u32x4 __attribute__((ext_vector_type(4)));
typedef unsigned u32x2 __attribute__((ext_vector_type(2)));

#define DEV __device__ __forceinline__
#define NO_SB_EXIT 0
#define DBG_REP_ATTN 1
#define DBG_REP_GU 2
#define DBG_SKIP_SB 0
#define DBG_NOSHFL 0
#define DBG_SKIP_FOX 0
#define DBG_OFF1 OFF_EB
#define DBG_OFF2 OFF_VT

constexpr int M_TOK = 32768, SEQ = 4096, DM = 1024, DFF = 2816;
constexpr float EPS = 1e-6f;
constexpr float LOG2E = 1.4426950408889634f;

constexpr size_t SZ_EVIN = 3200ull * 1024, SZ_ODIN = 2048ull * 1024, SZ_OUT = 1024ull * 1024, SZ_GU = 5632ull * 1024,
                 SZ_DN = 1024ull * 2816, SZ_QB = 768ull * 256, SZ_KVB = 1024ull * 128;
constexpr size_t OFF_EVIN = 0;
constexpr size_t OFF_ODIN = OFF_EVIN + 2 * SZ_EVIN * 2;
constexpr size_t OFF_EVOUT = OFF_ODIN + 2 * SZ_ODIN * 2;
constexpr size_t OFF_ODOUT = OFF_EVOUT + 2 * SZ_OUT * 2;
constexpr size_t OFF_GU = OFF_ODOUT + 2 * SZ_OUT * 2;
constexpr size_t OFF_DN = OFF_GU + 4 * SZ_GU * 2;
constexpr size_t OFF_QB = OFF_DN + 4 * SZ_DN * 2;
constexpr size_t OFF_KVB = OFF_QB + 2 * SZ_QB * 2;
constexpr size_t OFF_HM = OFF_KVB + 2 * SZ_KVB * 2;
constexpr size_t OFF_EB = OFF_HM + (size_t)M_TOK * 1024 * 2;
constexpr size_t OFF_VT = OFF_EB + (size_t)M_TOK * 2048 * 2;
constexpr size_t OFF_QD = OFF_VT + (size_t)M_TOK * 1024 * 2;
constexpr size_t OFF_KD = OFF_QD + (size_t)M_TOK * 768 * 2;
constexpr size_t OFF_FA = OFF_KD + (size_t)M_TOK * 768 * 2;
constexpr size_t OFF_CDEC = OFF_FA + (size_t)M_TOK * 8 * 4;
constexpr size_t OFF_KMEAN = OFF_CDEC + 64ull * 4096 * 4;
constexpr size_t OFF_SEL = OFF_KMEAN + 8ull * 8 * 16 * 64 * 4;
constexpr size_t OFF_BTAB = OFF_SEL + 64ull * 4096 * 4;
constexpr size_t OFF_ROPE = OFF_BTAB + 8ull * 128 * 4;
constexpr size_t OFF_END = OFF_ROPE + 2ull * 4096 * 16 * 4;
constexpr size_t OFF_BAR = OFF_END;
constexpr size_t OFF_ACT = OFF_EB;
static_assert((size_t)M_TOK * DFF * 2 <= (size_t)M_TOK * 3072 * 2, "ACT overlay");

constexpr int SMEM_BYTES = 131072;
constexpr int NT = 512;

struct Params {
    const float* x; const float* ffn_norm; const float* w_gu; const float* w_dn; const float* rel_bias;
    const float* ev_norm; const float* ev_w_in; const float* ev_fb; const float* ev_qn; const float* ev_kn; const float* ev_w_out;
    const float* od_norm; const float* od_w_in; const float* od_mqn; const float* od_mkn; const float* od_qan; const float* od_wqb;
    const float* od_kvan; const float* od_wkvb; const float* od_lqn; const float* od_lkn; const float* od_w_out;
    float* out; char* ws;
};

typedef __bf16 bf16v2_t __attribute__((ext_vector_type(2)));
typedef float f32x2_t __attribute__((ext_vector_type(2)));
DEV unsigned pk_bf16(float lo, float hi) { f32x2_t v = {lo, hi}; bf16v2_t b = __builtin_convertvector(v, bf16v2_t); return __builtin_bit_cast(unsigned, b); }
DEV int opq_v(int x) { asm volatile("" : "+v"(x)); return x; }
DEV int opq_s(int x) { asm volatile("" : "+s"(x)); return x; }
#define TID opq_v((int)threadIdx.x)
#define BID opq_s((int)blockIdx.x)
DEV float bf_lo(unsigned u) { return __uint_as_float(u << 16); }
DEV float bf_hi(unsigned u) { return __uint_as_float(u & 0xffff0000u); }

enum { WM_ID = 0, WM_EVIN, WM_ODIN, WM_GU, WM_KVB };
DEV int srcmap(int mode, int n) {
    switch (mode) {
    case WM_EVIN:
        if (n < 1024) return n;
        if (n < 1536) return 1544 + (n - 1024);
        if (n < 2048) return 2056 + (n - 1536);
        if (n < 2560) return 1024 + (n - 2048);
        if (n < 3072) return 2568 + (n - 2560);
        return -1;
    case WM_ODIN:
        if (n < 1024) return n;
        if (n < 1280) return 1536 + (n - 1024);
        if (n < 1408) return 1792 + (n - 1280);
        if (n < 1440) return 1920 + (n - 1408);
        if (n < 1536) return -1;
        return 1024 + (n - 1536);
    case WM_GU: { const int pn = n >> 8, bj = (n >> 7) & 1, t = n & 127; return bj * 2816 + 128 * pn + t; }
    case WM_KVB: { if (n < 512) return (n >> 6) * 128 + (n & 63); int m = n - 512; return (m >> 6) * 128 + 64 + (m & 63); }
    default: return n;
    }
}

DEV void convert_matrix(const float* __restrict__ W, bf16_t* __restrict__ Bt, int K, int N, int Np, int mode, float* lds) {
    const int tid = TID;
    const int nkt = K >> 6, ntiles = (Np >> 6) * nkt;
    for (int t = BID; t < ntiles; t += gridDim.x) {
        const int k0 = (t % nkt) << 6, n0 = (t / nkt) << 6;
        const int nn = tid & 63, src = srcmap(mode, n0 + nn);
        __syncthreads();
#pragma unroll 4
        for (int i = 0; i < 8; ++i) {
            const int kk = (tid >> 6) + 8 * i;
            lds[nn * 65 + kk] = src >= 0 ? W[(size_t)(k0 + kk) * N + src] : 0.f;
        }
        __syncthreads();
        const int r = tid >> 3, c = tid & 7;
        const float* lp = lds + r * 65 + c * 8;
        u32x4 a;
        a.x = pk_bf16(lp[0], lp[1]); a.y = pk_bf16(lp[2], lp[3]); a.z = pk_bf16(lp[4], lp[5]); a.w = pk_bf16(lp[6], lp[7]);
        *(u32x4*)(Bt + (size_t)(n0 + r) * K + k0 + c * 8) = a;
    }
}

DEV void prologue(const Params& p, char* smem) {
    float* lds = (float*)smem;
    char* ws = p.ws;
    for (int i = 0; i < 2; ++i) {
        convert_matrix(p.ev_w_in + (size_t)i * 1024 * 3080, (bf16_t*)(ws + OFF_EVIN) + i * SZ_EVIN, 1024, 3080, 3072, WM_EVIN, lds);
        convert_matrix(p.od_w_in + (size_t)i * 1024 * 1952, (bf16_t*)(ws + OFF_ODIN) + i * SZ_ODIN, 1024, 1952, 2048, WM_ODIN, lds);
        convert_matrix(p.ev_w_out + (size_t)i * 1024 * 1024, (bf16_t*)(ws + OFF_EVOUT) + i * SZ_OUT, 1024, 1024, 1024, WM_ID, lds);
        convert_matrix(p.od_w_out + (size_t)i * 1024 * 1024, (bf16_t*)(ws + OFF_ODOUT) + i * SZ_OUT, 1024, 1024, 1024, WM_ID, lds);
        convert_matrix(p.od_wqb + (size_t)i * 256 * 768, (bf16_t*)(ws + OFF_QB) + i * SZ_QB, 256, 768, 768, WM_ID, lds);
        convert_matrix(p.od_wkvb + (size_t)i * 128 * 1024, (bf16_t*)(ws + OFF_KVB) + i * SZ_KVB, 128, 1024, 1024, WM_KVB, lds);
    }
    for (int l = 0; l < 4; ++l) {
        convert_matrix(p.w_gu + (size_t)l * 1024 * 5632, (bf16_t*)(ws + OFF_GU) + l * SZ_GU, 1024, 5632, 5632, WM_GU, lds);
        convert_matrix(p.w_dn + (size_t)l * 2816 * 1024, (bf16_t*)(ws + OFF_DN) + l * SZ_DN, 2816, 1024, 1024, WM_ID, lds);
    }
    const int gt = BID * blockDim.x + TID, gn = gridDim.x * blockDim.x;
    float* btab = (float*)(ws + OFF_BTAB);
    for (int i = gt; i < 8 * 128; i += gn) {
        const int h = i >> 7, n = i & 127;
        int bucket;
        if (n < 16) bucket = n;
        else { const float v = logf((float)n / 16.0f) / 2.0794415416798357f * 16.0f; bucket = 16 + (int)v; if (bucket > 31) bucket = 31; }
        btab[i] = p.rel_bias[h * 32 + bucket] * LOG2E;
    }
    float* rope = (float*)(ws + OFF_ROPE);
    for (int i = gt; i < 4096 * 16; i += gn) {
        const int pos = i >> 4, f = i & 15;
        const float inv = powf(10000.0f, -(float)f / 16.0f);
        const float ang = (float)pos * inv;
        const double a = (double)ang;
        const double r = a - 6.283185307179586476925 * rint(a * 0.15915494309189533577);
        const float fr_ = (float)(r * 0.15915494309189533577);
        rope[i] = __builtin_amdgcn_cosf(fr_);
        rope[4096 * 16 + i] = __builtin_amdgcn_sinf(fr_);
    }
}

DEV void norm_phase(const float* __restrict__ x, const float* __restrict__ gain, bf16_t* __restrict__ h, const float* __restrict__ wfa, float* __restrict__ FA, char* smem) {
    const int tid = TID, lane = tid & 63, wv = (BID * NT + tid) >> 6, nw = (gridDim.x * NT) >> 6;
    float* wl = (float*)smem;
    if (wfa) {
        __syncthreads();
        for (int i = tid; i < 8192; i += NT) { const int k = i >> 3, j = i & 7; wl[j * 1024 + k] = wfa[(size_t)k * 3080 + 1536 + j]; }
        __syncthreads();
    }
    f32x4 g[4];
#pragma unroll
    for (int i = 0; i < 4; ++i) g[i] = *(const f32x4*)(gain + 4 * (lane + 64 * i));
    for (int row = wv; row < M_TOK; row += nw) {
        const float* xr = x + (size_t)row * DM;
        f32x4 v[4]; float ss = 0.f;
#pragma unroll
        for (int i = 0; i < 4; ++i) { v[i] = *(const f32x4*)(xr + 4 * (lane + 64 * i)); ss += v[i][0] * v[i][0] + v[i][1] * v[i][1] + v[i][2] * v[i][2] + v[i][3] * v[i][3]; }
#pragma unroll
        for (int o = 32; o > 0; o >>= 1) ss += __shfl_xor(ss, o);
        const float rstd = rsqrtf(ss * (1.0f / DM) + EPS);
        bf16_t* hr = h + (size_t)row * DM;
#pragma unroll
        for (int i = 0; i < 4; ++i) {
            v[i] = v[i] * rstd * g[i];
            u32x2 o; o.x = pk_bf16(v[i][0], v[i][1]); o.y = pk_bf16(v[i][2], v[i][3]);
            *(u32x2*)(hr + 4 * (lane + 64 * i)) = o;
        }
        if (wfa) {
            float fs[8];
#pragma unroll
            for (int j = 0; j < 8; ++j) {
                float a = 0.f;
#pragma unroll
                for (int i = 0; i < 4; ++i) { const f32x4 w = *(const f32x4*)(wl + j * 1024 + 4 * (lane + 64 * i)); a += v[i][0] * w[0] + v[i][1] * w[1] + v[i][2] * w[2] + v[i][3] * w[3]; }
#pragma unroll
                for (int o = 32; o > 0; o >>= 1) a += __shfl_xor(a, o);
                fs[j] = a;
            }
            if (lane == 0) { *(f32x4*)(FA + (size_t)row * 8) = (f32x4){fs[0], fs[1], fs[2], fs[3]}; *(f32x4*)(FA + (size_t)row * 8 + 4) = (f32x4){fs[4], fs[5], fs[6], fs[7]}; }
        }
    }
}

namespace pg8 {
#define PG8_LAS __attribute__((address_space(3)))
constexpr int BM = 256, BK = 64, HALF = 128, HTB = HALF * BK * 2, STAGE_BYTES = 8 * HTB, NXCD = 8, WGM = 8;
DEV int lds_byte(int r, int c) { const int st = (r >> 4) * 2 + (c >> 5), rr = r & 15, cc = c & 31, ob = rr * 64 + cc * 2; return st * 1024 + (ob ^ (((ob >> 9) & 1) << 5)); }
DEV void stage_rc(int b, int& R, int& C) { const int st = b / 1024, sb = b % 1024, swz = sb ^ (((sb >> 9) & 1) << 5); R = (st >> 1) * 16 + swz / 64; C = (st & 1) * 32 + (swz % 64) / 2; }
DEV int perm32(int rho) { const int n = rho >> 4, i = rho & 15; return 8 * (i >> 2) + 4 * n + (i & 3); }
struct Unit { int pm, pn; };
struct Gemm { const bf16_t* A; const bf16_t* Bt; int M, N, K, ldA, ldB; };
struct StaticOrder {
    int nM, nN, nwg, G, c;
    DEV void init(int M, int N, int G_, int c_) { nM = M / BM; nN = N / BM; nwg = nM * nN; G = G_; c = c_; }
    DEV bool next(int i, Unit& u) const {
        const long L = (long)i * G + c; if (L >= nwg) return false;
        int wgid = (int)L; { const int q = nwg / NXCD, r = nwg % NXCD, xcd = wgid % NXCD, off = wgid / NXCD; wgid = (xcd < r ? xcd * (q + 1) : r * (q + 1) + (xcd - r) * q) + off; }
        const int nig = WGM * nN, gid = wgid / nig, fm = gid * WGM, gsz = (nM - fm) < WGM ? (nM - fm) : WGM;
        u.pm = fm + ((wgid % nig) % gsz); u.pn = (wgid % nig) / gsz; return true;
    }
};
template <class Epi>
DEV void gemm_phase(PG8_LAS unsigned char* lds, const Gemm g, const StaticOrder& S, const Epi& E) {
    const int tid = TID, wid = __builtin_amdgcn_readfirstlane(tid >> 6), lane = tid & 63, wr = wid >> 2, wc = wid & 3, fr = lane & 15, fq = lane >> 4;
    const int K = g.K, nt = K / BK;
    unsigned voffA[2], voffB[2];
#pragma unroll
    for (int i = 0; i < 2; ++i) { int R, C; stage_rc(tid * 16 + i * 8192, R, C); const int Rb = (R & ~31) + perm32(R & 31);
        voffA[i] = (unsigned)(R * g.ldA + C) * 2u; voffB[i] = (unsigned)(Rb * g.ldB + C) * 2u; }
    const size_t kstep = (size_t)(BK * 2);
    const size_t hstepA = (size_t)HALF * g.ldA * 2, hstepB = (size_t)HALF * g.ldB * 2, tstepA = 2 * hstepA, tstepB = 2 * hstepB;
    const unsigned ldsw = (unsigned)wid * 1024u;
    const int aoff = lds_byte(wr * 64 + fr, fq * 8), boff = lds_byte(wc * 32 + fr, fq * 8);
#define PG8_SA(b, h) (((b) * 2 + (h)) * HTB)
#define PG8_SB(b, h) ((4 + (b) * 2 + (h)) * HTB)
#define PG8_STAGE(bufoff, gbase, voff) do { _Pragma("unroll") for (int _i = 0; _i < 2; ++_i) \
        __builtin_amdgcn_global_load_lds((const unsigned*)((const char*)(gbase) + (voff)[_i]), (PG8_LAS unsigned*)(lds + (bufoff) + ldsw + _i * 8192), 16, 0, 0); } while (0)
#define PG8_LDA(dst, b, h) do { _Pragma("unroll") for (int m = 0; m < 4; ++m) _Pragma("unroll") for (int k = 0; k < 2; ++k) dst[m][k] = *(const PG8_LAS bf16x8*)(lds + PG8_SA(b, h) + aoff + m * 2048 + k * 1024); } while (0)
#define PG8_LDB(dst, b, h) do { _Pragma("unroll") for (int n = 0; n < 2; ++n) _Pragma("unroll") for (int k = 0; k < 2; ++k) dst[n][k] = *(const PG8_LAS bf16x8*)(lds + PG8_SB(b, h) + boff + n * 2048 + k * 1024); } while (0)
#define PG8_MMA(ai, bj, At, Bt) do { __builtin_amdgcn_s_setprio(1); _Pragma("unroll") for (int m = 0; m < 4; ++m) _Pragma("unroll") for (int n = 0; n < 2; ++n) _Pragma("unroll") for (int k = 0; k < 2; ++k) \
        acc[ai][bj][m][n] = __builtin_amdgcn_mfma_f32_16x16x32_bf16(Bt[n][k], At[m][k], acc[ai][bj][m][n], 0, 0, 0); __builtin_amdgcn_s_setprio(0); } while (0)
#define PG8_WAIT_V(n) asm volatile("s_waitcnt vmcnt(" #n ")" ::: "memory")
#define PG8_WAIT_L(n) asm volatile("s_waitcnt lgkmcnt(" #n ")" ::: "memory")
#define PG8_BAR __builtin_amdgcn_s_barrier()
#define PG8_SCHED __builtin_amdgcn_sched_barrier(0)
    Unit cur, nxt; int ui = 0;
    if (!S.next(0, cur)) return;
    f32x4 acc[2][2][4][2];
#pragma unroll
    for (int a = 0; a < 2; ++a)
#pragma unroll
        for (int b = 0; b < 2; ++b)
#pragma unroll
            for (int m = 0; m < 4; ++m)
#pragma unroll
                for (int n = 0; n < 2; ++n) acc[a][b][m][n] = (f32x4){0.f, 0.f, 0.f, 0.f};
    bf16x8 At[4][2], B0[2][2], B1[2][2];
    const char* cA = (const char*)g.A + (size_t)cur.pm * tstepA; const char* cB = (const char*)g.Bt + (size_t)cur.pn * tstepB;
    PG8_STAGE(PG8_SB(0, 0), cB, voffB); PG8_STAGE(PG8_SB(0, 1), cB + hstepB, voffB); PG8_STAGE(PG8_SA(0, 0), cA, voffA); PG8_STAGE(PG8_SA(0, 1), cA + hstepA, voffA);
    if (wr == 1) PG8_BAR;
    PG8_WAIT_V(2); PG8_BAR;
    PG8_STAGE(PG8_SB(1, 0), cB + kstep, voffB); PG8_STAGE(PG8_SA(1, 0), cA + kstep, voffA); PG8_STAGE(PG8_SB(1, 1), cB + hstepB + kstep, voffB);
    PG8_WAIT_V(6); PG8_BAR;
    for (;;) {
        const bool has_next = S.next(ui + 1, nxt);
        const char* nA = has_next ? (const char*)g.A + (size_t)nxt.pm * tstepA : cA; const char* nB = has_next ? (const char*)g.Bt + (size_t)nxt.pn * tstepB : cB;
        for (int t = 0; t < nt; t += 2) {
            const bool last = (t == nt - 2);
            const char* a1 = cA + (size_t)(t + 1) * kstep;
            const char* a2 = last ? nA : cA + (size_t)(t + 2) * kstep; const char* b2 = last ? nB : cB + (size_t)(t + 2) * kstep;
            const char* a3 = a2 + kstep; const char* b3 = b2 + kstep;
            PG8_LDB(B0, 0, 0); PG8_LDB(B1, 0, 1); PG8_SCHED; PG8_LDA(At, 0, 0); PG8_STAGE(PG8_SA(1, 1), a1 + hstepA, voffA);
            PG8_WAIT_V(8); PG8_WAIT_L(0); PG8_BAR; PG8_MMA(0, 0, At, B0); PG8_MMA(0, 1, At, B1); PG8_BAR; PG8_SCHED;
            PG8_LDA(At, 0, 1); PG8_STAGE(PG8_SB(0, 0), b2, voffB); PG8_STAGE(PG8_SB(0, 1), b2 + hstepB, voffB); PG8_STAGE(PG8_SA(0, 0), a2, voffA);
            PG8_WAIT_V(8); PG8_WAIT_L(0); PG8_BAR; PG8_MMA(1, 0, At, B0); PG8_MMA(1, 1, At, B1); PG8_BAR; PG8_SCHED;
            PG8_LDB(B0, 1, 0); PG8_LDB(B1, 1, 1); PG8_SCHED; PG8_LDA(At, 1, 0); PG8_STAGE(PG8_SA(0, 1), a2 + hstepA, voffA);
            PG8_WAIT_V(8); PG8_WAIT_L(0); PG8_BAR; PG8_MMA(0, 0, At, B0); PG8_MMA(0, 1, At, B1); PG8_BAR; PG8_SCHED;
            PG8_LDA(At, 1, 1); PG8_STAGE(PG8_SB(1, 0), b3, voffB); PG8_STAGE(PG8_SB(1, 1), b3 + hstepB, voffB); PG8_STAGE(PG8_SA(1, 0), a3, voffA);
            PG8_WAIT_V(8); PG8_WAIT_L(0); PG8_BAR; PG8_MMA(1, 0, At, B0); PG8_MMA(1, 1, At, B1); PG8_BAR; PG8_SCHED;
        }
        if (wr == 0) PG8_BAR;
        E(acc, cur, wr, wc, fr, fq);
        if (!has_next) break;
#pragma unroll
        for (int a = 0; a < 2; ++a)
#pragma unroll
            for (int b = 0; b < 2; ++b)
#pragma unroll
                for (int m = 0; m < 4; ++m)
#pragma unroll
                    for (int n = 0; n < 2; ++n) acc[a][b][m][n] = (f32x4){0.f, 0.f, 0.f, 0.f};
        cur = nxt; cA = nA; cB = nB; ++ui;
        if (wr == 1) PG8_BAR;
    }
    PG8_WAIT_V(0);
    PG8_BAR;
#undef PG8_SA
#undef PG8_SB
#undef PG8_STAGE
#undef PG8_LDA
#undef PG8_LDB
#undef PG8_MMA
#undef PG8_WAIT_V
#undef PG8_WAIT_L
#undef PG8_BAR
#undef PG8_SCHED
}
}

typedef f32x4 AccT[2][2][4][2];
DEV u32x4 pack8(const f32x4& a, const f32x4& b) { u32x4 w; w.x = pk_bf16(a[0], a[1]); w.y = pk_bf16(a[2], a[3]); w.z = pk_bf16(b[0], b[1]); w.w = pk_bf16(b[2], b[3]); return w; }

struct EpiPlain {
    bf16_t* C; int ldc; int kd;
    DEV void operator()(const AccT& acc, const pg8::Unit& u, int wr, int wc, int fr, int fq) const {
        const int row0 = u.pm * 256 + wr * 64 + fr, col0 = u.pn * 256 + wc * 32 + 8 * fq;
#pragma unroll
        for (int ai = 0; ai < 2; ++ai)
#pragma unroll
            for (int m = 0; m < 4; ++m) {
                bf16_t* rowp = C + (size_t)(row0 + ai * 128 + m * 16) * ldc;
#pragma unroll
                for (int bj = 0; bj < 2; ++bj) { int col = col0 + bj * 128; if (kd) col = (col >> 6) * 96 + (col & 63);
                    *(u32x4*)(rowp + col) = pack8(acc[ai][bj][m][0], acc[ai][bj][m][1]); }
            }
    }
};
struct EpiResid {
    const float* xin; float* xout;
    DEV void operator()(const AccT& acc, const pg8::Unit& u, int wr, int wc, int fr, int fq) const {
        const int row0 = u.pm * 256 + wr * 64 + fr, col0 = u.pn * 256 + wc * 32 + 8 * fq;
#pragma unroll
        for (int ai = 0; ai < 2; ++ai)
#pragma unroll
            for (int m = 0; m < 4; ++m) {
                const size_t ro = (size_t)(row0 + ai * 128 + m * 16) * DM;
#pragma unroll
                for (int bj = 0; bj < 2; ++bj) { const size_t o = ro + col0 + bj * 128;
                    const f32x4 x0 = *(const f32x4*)(xin + o), x1 = *(const f32x4*)(xin + o + 4);
                    *(f32x4*)(xout + o) = x0 + acc[ai][bj][m][0]; *(f32x4*)(xout + o + 4) = x1 + acc[ai][bj][m][1]; }
            }
    }
};
struct EpiSwiglu {
    bf16_t* ACT;
    DEV void operator()(const AccT& acc, const pg8::Unit& u, int wr, int wc, int fr, int fq) const {
        const int row0 = u.pm * 256 + wr * 64 + fr, col0 = u.pn * 128 + wc * 32 + 8 * fq;
#pragma unroll
        for (int ai = 0; ai < 2; ++ai)
#pragma unroll
            for (int m = 0; m < 4; ++m) {
                f32x4 o[2];
#pragma unroll
                for (int n = 0; n < 2; ++n)
#pragma unroll
                    for (int j = 0; j < 4; ++j) { const float gv = acc[ai][0][m][n][j], uv = acc[ai][1][m][n][j]; o[n][j] = gv / (1.0f + __expf(-gv)) * uv; }
                *(u32x4*)(ACT + (size_t)(row0 + ai * 128 + m * 16) * DFF + col0) = pack8(o[0], o[1]);
            }
    }
};
struct EpiVT {
    bf16_t* VT; int head_base;
    DEV void operator()(const AccT& acc, const pg8::Unit& u, int wr, int wc, int fr, int fq) const {
        const int r0 = u.pm * 256 + wr * 64 + fr, c0 = u.pn * 256 + wc * 32 + 8 * fq;
#pragma unroll
        for (int ai = 0; ai < 2; ++ai)
#pragma unroll
            for (int m = 0; m < 4; ++m) {
                const int r = r0 + ai * 128 + m * 16, head = head_base + (r >> 6), d = r & 63;
#pragma unroll
                for (int bj = 0; bj < 2; ++bj) { const int c = c0 + bj * 128, b = c >> 12, sq = c & 4095;
                    *(u32x4*)(VT + ((size_t)((b * 16 + head) * 64 + d)) * 4096 + sq) = pack8(acc[ai][bj][m][0], acc[ai][bj][m][1]); }
            }
    }
};
template <class Epi>
DEV void run_gemm(char* smem, const bf16_t* A, int ldA, int M, const bf16_t* Bt, int ldB, int N, int K, const Epi& E) {
    __syncthreads();
    pg8::Gemm g{A, Bt, M, N, K, ldA, ldB}; pg8::StaticOrder S; S.init(M, N, (int)gridDim.x, BID);
    pg8::gemm_phase<Epi>((PG8_LAS unsigned char*)smem, g, S, E);
    __syncthreads();
}

template <int LPR, bool MEAN>
DEV void rownorm_block(bf16_t* buf, int ld, int col0, const float* __restrict__ gain, int row0, float* kmean_out, float* red) {
    constexpr int RPI = NT / LPR;
    const int tid = TID, sub = tid % LPR, rr = tid / LPR;
    float g[8], am[8];
#pragma unroll
    for (int i = 0; i < 8; ++i) { g[i] = gain[sub * 8 + i]; am[i] = 0.f; }
    for (int it = 0; it < 256 / RPI; ++it) {
        bf16_t* rp = buf + (size_t)(row0 + it * RPI + rr) * ld + col0 + sub * 8;
        const u32x4 v = *(const u32x4*)rp;
        float x[8] = {bf_lo(v.x), bf_hi(v.x), bf_lo(v.y), bf_hi(v.y), bf_lo(v.z), bf_hi(v.z), bf_lo(v.w), bf_hi(v.w)};
        float ss = 0.f;
#pragma unroll
        for (int i = 0; i < 8; ++i) ss += x[i] * x[i];
#pragma unroll
        for (int o = 1; o < LPR; o <<= 1) ss += __shfl_xor(ss, o);
        const float rstd = rsqrtf(ss * (1.0f / (LPR * 8)) + EPS);
#pragma unroll
        for (int i = 0; i < 8; ++i) { x[i] = x[i] * rstd * g[i]; if (MEAN) am[i] += x[i]; }
        u32x4 o; o.x = pk_bf16(x[0], x[1]); o.y = pk_bf16(x[2], x[3]); o.z = pk_bf16(x[4], x[5]); o.w = pk_bf16(x[6], x[7]);
        *(u32x4*)rp = o;
    }
    if (MEAN) {
        __syncthreads();
#pragma unroll
        for (int i = 0; i < 8; ++i) red[rr * 64 + sub * 8 + i] = am[i];
        __syncthreads();
        if (tid < 64) {
            float s = 0.f;
            for (int r = 0; r < RPI; ++r) s += red[r * 64 + tid];
            kmean_out[tid] = s * (1.0f / 256.0f);
        }
    }
}

DEV void even_post(const Params& p, int li, char* smem) {
    char* ws = p.ws;
    bf16_t* EB = (bf16_t*)(ws + OFF_EB);
    float* red = (float*)smem;
    for (int it = BID; it < 2048 + 64; it += gridDim.x) {
        if (it < 2048) {
            const int blk = it >> 4, hh = it & 15;
            rownorm_block<8, false>(EB, 2048, hh * 64, (hh < 8 ? p.ev_qn : p.ev_kn) + li * 64, blk * 256, nullptr, red);
        } else {
            const int bh = it - 2048, b = bh >> 3, h = bh & 7, tid = TID, lane = tid & 63, wid = tid >> 6;
            const float* FA = (const float*)(ws + OFF_FA);
            float* CD = (float*)(ws + OFF_CDEC) + (size_t)bh * 4096;
            const float fb = p.ev_fb[li * 8 + h];
            float lf[8]; float run = 0.f;
#pragma unroll
            for (int i = 0; i < 8; ++i) {
                const float z = FA[(size_t)(b * 4096 + tid * 8 + i) * 8 + h] + fb;
                const float ls = fminf(z, 0.f) - log1pf(expf(-fabsf(z)));
                run += ls; lf[i] = run;
            }
            float inc = run;
#pragma unroll
            for (int o = 1; o < 64; o <<= 1) { const float y = __shfl_up(inc, o); if (lane >= o) inc += y; }
            __syncthreads();
            if (lane == 63) red[wid] = inc;
            __syncthreads();
            float base = inc - run;
            for (int w = 0; w < wid; ++w) base += red[w];
#pragma unroll
            for (int i = 0; i < 8; ++i) CD[tid * 8 + i] = (base + lf[i]) * LOG2E;
            __syncthreads();
        }
    }
}

DEV void odd_post1(const Params& p, int li, char* smem) {
    char* ws = p.ws;
    bf16_t* OB = (bf16_t*)(ws + OFF_EB);
    float* red = (float*)smem;
    float* KM = (float*)(ws + OFF_KMEAN);
    for (int it = BID; it < 2304; it += gridDim.x) {
        if (it < 1024) {
            const int blk = it >> 3, h = it & 7, b = blk >> 4, nb = blk & 15;
            rownorm_block<8, true>(OB, 1536, 512 + h * 64, p.od_mkn + li * 64, blk * 256, KM + (size_t)((b * 8 + h) * 16 + nb) * 64, red);
            __syncthreads();
        } else if (it < 2048) {
            const int j = it - 1024, blk = j >> 3, h = j & 7;
            rownorm_block<8, false>(OB, 1536, h * 64, p.od_mqn + li * 64, blk * 256, nullptr, red);
        } else if (it < 2176) {
            rownorm_block<32, false>(OB, 1536, 1024, p.od_qan + li * 256, (it - 2048) * 256, nullptr, red);
        } else {
            rownorm_block<16, false>(OB, 1536, 1280, p.od_kvan + li * 128, (it - 2176) * 256, nullptr, red);
        }
    }
}

DEV void moba_gate(const Params& p) {
    char* ws = p.ws;
    const bf16_t* OB = (const bf16_t*)(ws + OFF_EB);
    const float* KM = (const float*)(ws + OFF_KMEAN);
    int* SEL = (int*)(ws + OFF_SEL);
    const int gt = BID * blockDim.x + TID, gn = gridDim.x * blockDim.x;
    for (int w = gt; w < 8 * M_TOK; w += gn) {
        const int h = w >> 15, token = w & (M_TOK - 1), b = token >> 12, s = token & 4095, cur = s >> 8;
        float q[64];
        const u32x4* qp = (const u32x4*)(OB + (size_t)token * 1536 + h * 64);
#pragma unroll
        for (int i = 0; i < 8; ++i) { const u32x4 v = qp[i]; q[8 * i] = bf_lo(v.x); q[8 * i + 1] = bf_hi(v.x); q[8 * i + 2] = bf_lo(v.y); q[8 * i + 3] = bf_hi(v.y);
            q[8 * i + 4] = bf_lo(v.z); q[8 * i + 5] = bf_hi(v.z); q[8 * i + 6] = bf_lo(v.w); q[8 * i + 7] = bf_hi(v.w); }
        float v1 = -INFINITY, v2 = -INFINITY, v3 = -INFINITY; int i1 = -1, i2 = -1, i3 = -1;
        const float* kmb = KM + (size_t)((b * 8 + h) * 16) * 64;
        for (int n = 0; n < cur; ++n) {
            const f32x4* km = (const f32x4*)(kmb + n * 64);
            float d = 0.f;
#pragma unroll
            for (int i = 0; i < 16; ++i) { const f32x4 k4 = km[i]; d += q[4 * i] * k4[0] + q[4 * i + 1] * k4[1] + q[4 * i + 2] * k4[2] + q[4 * i + 3] * k4[3]; }
            if (d > v1) { v3 = v2; i3 = i2; v2 = v1; i2 = i1; v1 = d; i1 = n; }
            else if (d > v2) { v3 = v2; i3 = i2; v2 = d; i2 = n; }
            else if (d > v3) { v3 = d; i3 = n; }
        }
        int m = 0;
        if (i1 >= 0) m |= 1 << i1;
        if (i2 >= 0) m |= 1 << i2;
        if (i3 >= 0) m |= 1 << i3;
        SEL[(size_t)(b * 8 + h) * 4096 + s] = m;
    }
}

DEV void mla_post(const Params& p, int li) {
    char* ws = p.ws;
    bf16_t* QD = (bf16_t*)(ws + OFF_QD);
    bf16_t* KD = (bf16_t*)(ws + OFF_KD);
    const bf16_t* OB = (const bf16_t*)(ws + OFF_EB);
    const float* rope = (const float*)(ws + OFF_ROPE);
    const int gt = BID * blockDim.x + TID, gn = gridDim.x * blockDim.x;
    for (int w = gt; w < 2 * 8 * M_TOK; w += gn) {
        const int isk = w >> 18, rem = w & ((1 << 18) - 1), token = rem >> 3, h = rem & 7, s = token & 4095;
        bf16_t* rp = (isk ? KD : QD) + (size_t)token * 768 + h * 96;
        const float* gain = (isk ? p.od_lkn : p.od_lqn) + li * 96;
        float x[96];
#pragma unroll
        for (int i = 0; i < 12; ++i) {
            u32x4 v;
            if (isk && i >= 8) v = *(const u32x4*)(OB + (size_t)token * 1536 + 1408 + (i - 8) * 8);
            else v = *(const u32x4*)(rp + i * 8);
            x[8 * i] = bf_lo(v.x); x[8 * i + 1] = bf_hi(v.x); x[8 * i + 2] = bf_lo(v.y); x[8 * i + 3] = bf_hi(v.y);
            x[8 * i + 4] = bf_lo(v.z); x[8 * i + 5] = bf_hi(v.z); x[8 * i + 6] = bf_lo(v.w); x[8 * i + 7] = bf_hi(v.w);
        }
        float ss = 0.f;
#pragma unroll
        for (int i = 0; i < 96; ++i) ss += x[i] * x[i];
        const float rstd = rsqrtf(ss * (1.0f / 96.0f) + EPS);
#pragma unroll
        for (int i = 0; i < 96; ++i) x[i] = x[i] * rstd * gain[i];
        const float* cs = rope + (size_t)s * 16;
        const float* sn = rope + 4096 * 16 + (size_t)s * 16;
#pragma unroll
        for (int i = 0; i < 16; ++i) {
            const float c = cs[i], sv = sn[i], a = x[64 + i], bb = x[80 + i];
            x[64 + i] = a * c - bb * sv; x[80 + i] = a * sv + bb * c;
        }
#pragma unroll
        for (int i = 0; i < 12; ++i) {
            u32x4 o; o.x = pk_bf16(x[8 * i], x[8 * i + 1]); o.y = pk_bf16(x[8 * i + 2], x[8 * i + 3]); o.z = pk_bf16(x[8 * i + 4], x[8 * i + 5]); o.w = pk_bf16(x[8 * i + 6], x[8 * i + 7]);
            *(u32x4*)(rp + i * 8) = o;
        }
    }
}

enum { AT_FOX = 0, AT_SB, AT_MOBA, AT_MLA };
constexpr int AT_KBUF = 13312, AT_VBUF = 8192, AT_K0 = 0, AT_V0 = 2 * AT_KBUF, AT_MISC = AT_V0 + 2 * AT_VBUF, AT_CK = AT_MISC + 1024;

template <int MODE>
DEV void attn_item(const Params& p, char* smem, int b, int h, int qt) {
    constexpr int DQK = (MODE == AT_MLA) ? 96 : 64;
    constexpr int NKS = DQK / 32;
    constexpr int KSTRB = (DQK + 8) * 2;
    constexpr int KCH = DQK / 8;
    constexpr int KLD = (64 * KCH + NT - 1) / NT;
    char* ws = p.ws;
    const int tid = TID, wid = tid >> 6, lane = tid & 63, fr = lane & 15, fq = lane >> 4;
    const bf16_t* Qb; const bf16_t* Kb; int ldq; int head16;
    if (MODE == AT_FOX) { Qb = (const bf16_t*)(ws + OFF_EB) + h * 64; Kb = Qb + 512; ldq = 2048; head16 = h; }
    else if (MODE == AT_SB) { Qb = (const bf16_t*)(ws + OFF_EB) + 1024 + h * 64; Kb = Qb + 512; ldq = 2048; head16 = 8 + h; }
    else if (MODE == AT_MOBA) { Qb = (const bf16_t*)(ws + OFF_EB) + h * 64; Kb = Qb + 512; ldq = 1536; head16 = h; }
    else { Qb = (const bf16_t*)(ws + OFF_QD) + h * 96; Kb = (const bf16_t*)(ws + OFF_KD) + h * 96; ldq = 768; head16 = 8 + h; }
    const bf16_t* Vt = (const bf16_t*)(ws + OFF_VT) + (size_t)((b * 16 + head16) * 64) * 4096;
    const size_t tokb = (size_t)b * 4096;
    const int qw0 = qt * 128 + wid * 16;
    const int qpos = qw0 + fr;
    const int tlast = 2 * qt + 1;
    int* smi = (int*)(smem + AT_MISC);
    float* btab = (float*)(smem + AT_MISC + 512);

    __syncthreads();
    int mysel = 0;
    if (MODE == AT_MOBA) {
        mysel = ((const int*)(ws + OFF_SEL))[(size_t)(b * 8 + h) * 4096 + qpos];
        if (tid == 0) smi[73] = 0;
        if (tid < 128) btab[tid] = ((const float*)(ws + OFF_BTAB))[h * 128 + tid];
        __syncthreads();
        if (fq == 0) atomicOr(&smi[73], mysel);
        __syncthreads();
    }
    if (tid == 0) {
        int n = 0;
        if (MODE == AT_FOX || MODE == AT_MLA) { for (int t = 0; t <= tlast; ++t) smi[n++] = t; }
        else if (MODE == AT_SB) { for (int t = tlast; t >= 0; --t) smi[n++] = t; }
        else {
            const int cur = qt >> 1, um = smi[73];
            for (int t = cur * 4; t <= tlast; ++t) smi[n++] = t;
            for (int kb = 0; kb < cur; ++kb) if ((um >> kb) & 1) { for (int t = 0; t < 4; ++t) smi[n++] = kb * 4 + t; }
        }
        smi[72] = n;
    }
    __syncthreads();
    const int nt = smi[72];

    bf16x8 qf[NKS];
    {
        const bf16_t* qp = Qb + (tokb + qpos) * ldq + fq * 8;
#pragma unroll
        for (int ks = 0; ks < NKS; ++ks) qf[ks] = *(const bf16x8*)(qp + ks * 32);
    }
    float cq = 0.f;
    const float* CD = (const float*)(ws + OFF_CDEC) + (size_t)(b * 8 + h) * 4096;
    if (MODE == AT_FOX) cq = CD[qpos];
    const float c1 = (MODE == AT_MLA ? 0.10206207261596577f : 0.125f) * (MODE == AT_SB ? 1.0f : LOG2E);
    const float bfar = (MODE == AT_MOBA) ? btab[127] : 0.f;

    f32x4 o[4];
#pragma unroll
    for (int i = 0; i < 4; ++i) o[i] = (f32x4){0.f, 0.f, 0.f, 0.f};
    float mrun = -1e30f, lsum = 0.f, R = 0.f;

    u32x4 rk[KLD], rv; f32x4 rc = (f32x4){0.f, 0.f, 0.f, 0.f};
    auto gload = [&](int tile) {
        if (MODE == AT_FOX) { if (tid < 16) rc = *(const f32x4*)(CD + tile * 64 + tid * 4); }
#pragma unroll
        for (int i = 0; i < KLD; ++i) { const int idx = tid + NT * i, r = idx / KCH, c = idx % KCH; if (idx < 64 * KCH) rk[i] = *(const u32x4*)(Kb + (tokb + tile * 64 + r) * ldq + c * 8); }
        { const int d = tid >> 3, c8 = tid & 7; rv = *(const u32x4*)(Vt + (size_t)d * 4096 + tile * 64 + c8 * 8); }
    };
    auto lstore = [&](int buf) {
        char* kb = smem + AT_K0 + buf * AT_KBUF; char* vb = smem + AT_V0 + buf * AT_VBUF;
        if (MODE == AT_FOX) { if (tid < 16) *(f32x4*)(smem + AT_CK + buf * 256 + tid * 16) = rc; }
#pragma unroll
        for (int i = 0; i < KLD; ++i) { const int idx = tid + NT * i, r = idx / KCH, c = idx % KCH; if (idx < 64 * KCH) *(u32x4*)(kb + r * KSTRB + c * 16) = rk[i]; }
        { const int d = tid >> 3, c8 = tid & 7; *(u32x4*)(vb + ((c8 >> 1) * 64 + d) * 32 + (c8 & 1) * 16) = rv; }
    };
    gload(smi[0]); lstore(0);
    __syncthreads();
    for (int it = 0; it < nt; ++it) {
        const int tile = smi[it], buf = it & 1;
        const bool more = it + 1 < nt;
        if (more) gload(smi[it + 1]);
        const char* kb = smem + AT_K0 + buf * AT_KBUF; const char* vb = smem + AT_V0 + buf * AT_VBUF;
        const int kbase = tile * 64 + fq * 4;
        const bool wave_live = (MODE == AT_SB) ? (tile * 64 < qw0 + 15) : (tile * 64 <= qw0 + 15);
        const bool diag = (tile * 64 + 63 >= qw0);
        if (wave_live) {
        f32x4 s[4];
#pragma unroll
        for (int kt = 0; kt < 4; ++kt) {
            s[kt] = (f32x4){0.f, 0.f, 0.f, 0.f};
#pragma unroll
            for (int ks = 0; ks < NKS; ++ks) {
                const bf16x8 kf = *(const bf16x8*)(kb + (kt * 16 + fr) * KSTRB + (ks * 32 + fq * 8) * 2);
                s[kt] = __builtin_amdgcn_mfma_f32_16x16x32_bf16(kf, qf[ks], s[kt], 0, 0, 0);
            }
        }
        const bool far_tile = (MODE == AT_MOBA) && (qt * 128 - (tile * 64 + 63) >= 127);
        unsigned pp[4][2];
        if (MODE == AT_SB) {
            float T[4], exq[4], ls[4][4], e[4][4];
#pragma unroll
            for (int kt = 0; kt < 4; ++kt) {
                float v[4];
#pragma unroll
                for (int j = 0; j < 4; ++j) {
                    const float z = s[kt][j] * c1;
                    const float sp = __logf(1.0f + __expf(-fabsf(z)));
                    const float l = fminf(z, 0.f) - sp;
                    const bool strict = !diag || (kbase + kt * 16 + j < qpos);
                    ls[kt][j] = strict ? l : -INFINITY;
                    v[j] = strict ? (l - z) : 0.f;
                }
                e[kt][3] = 0.f; e[kt][2] = v[3]; e[kt][1] = v[3] + v[2]; e[kt][0] = e[kt][1] + v[1];
                const float G = e[kt][0] + v[0];
                float xs = G;
                float y = __shfl_down(xs, 16); if (fq < 3) xs += y;
                y = __shfl_down(xs, 32); if (fq < 2) xs += y;
                exq[kt] = xs - G;
                T[kt] = __shfl(xs, fr);
            }
            float off = R;
#pragma unroll
            for (int kt = 3; kt >= 0; --kt) {
                float w[4];
#pragma unroll
                for (int j = 0; j < 4; ++j) w[j] = __expf(ls[kt][j] + off + exq[kt] + e[kt][j]);
                pp[kt][0] = pk_bf16(w[0], w[1]); pp[kt][1] = pk_bf16(w[2], w[3]);
                off += T[kt];
            }
            R = off;
        } else {
            float t[4][4];
            float mx = -1e30f;
#pragma unroll
            for (int kt = 0; kt < 4; ++kt) {
                f32x4 bias = (f32x4){0.f, 0.f, 0.f, 0.f};
                if (MODE == AT_FOX) { const f32x4 ck = *(const f32x4*)(smem + AT_CK + buf * 256 + (kt * 16 + fq * 4) * 4); bias = (f32x4){cq, cq, cq, cq} - ck; }
                bool blk_ok = true;
                if (MODE == AT_MOBA) {
                    blk_ok = (tile >> 2) == (qt >> 1) || ((mysel >> (tile >> 2)) & 1);
                    if (far_tile) { bias = (f32x4){bfar, bfar, bfar, bfar}; }
                    else {
#pragma unroll
                        for (int j = 0; j < 4; ++j) { int dist = qpos - (kbase + kt * 16 + j); dist = dist < 0 ? 0 : (dist > 127 ? 127 : dist); bias[j] = btab[dist]; }
                    }
                }
#pragma unroll
                for (int j = 0; j < 4; ++j) {
                    float v = s[kt][j] * c1 + bias[j];
                    const bool ok = blk_ok && (!diag || (kbase + kt * 16 + j <= qpos));
                    v = ok ? v : -1e30f;
                    t[kt][j] = v; mx = fmaxf(mx, v);
                }
            }
            mx = fmaxf(mx, __shfl_xor(mx, 16)); mx = fmaxf(mx, __shfl_xor(mx, 32));
            const float mnew = fmaxf(mrun, mx);
            const float alpha = __builtin_amdgcn_exp2f(mrun - mnew);
            mrun = mnew;
            float ps = 0.f;
#pragma unroll
            for (int kt = 0; kt < 4; ++kt) {
                float w[4];
#pragma unroll
                for (int j = 0; j < 4; ++j) { w[j] = __builtin_amdgcn_exp2f(t[kt][j] - mnew); ps += w[j]; }
                pp[kt][0] = pk_bf16(w[0], w[1]); pp[kt][1] = pk_bf16(w[2], w[3]);
            }
            lsum = lsum * alpha + ps;
#pragma unroll
            for (int i = 0; i < 4; ++i) o[i] = o[i] * alpha;
        }
#pragma unroll
        for (int kk = 0; kk < 2; ++kk) {
            u32x4 pw; pw.x = pp[2 * kk][0]; pw.y = pp[2 * kk][1]; pw.z = pp[2 * kk + 1][0]; pw.w = pp[2 * kk + 1][1];
            const bf16x8 pf = __builtin_bit_cast(bf16x8, pw);
#pragma unroll
            for (int dt = 0; dt < 4; ++dt) {
                const u32x2 lo = *(const u32x2*)(vb + ((2 * kk) * 64 + dt * 16 + fr) * 32 + fq * 8);
                const u32x2 hi = *(const u32x2*)(vb + ((2 * kk + 1) * 64 + dt * 16 + fr) * 32 + fq * 8);
                u32x4 vw; vw.x = lo.x; vw.y = lo.y; vw.z = hi.x; vw.w = hi.y;
                o[dt] = __builtin_amdgcn_mfma_f32_16x16x32_bf16(__builtin_bit_cast(bf16x8, vw), pf, o[dt], 0, 0, 0);
            }
        }
        }
        if (more) lstore(buf ^ 1);
        if (MODE == AT_SB) {
            if (__syncthreads_and(R < -40.0f)) break;
        } else {
            __syncthreads();
        }
    }
    float inv = 1.0f;
    if (MODE != AT_SB) {
        float l = lsum; l += __shfl_xor(l, 16); l += __shfl_xor(l, 32);
        inv = 1.0f / l;
    }
    bf16_t* op = (bf16_t*)(ws + OFF_HM) + (tokb + qpos) * 1024 + head16 * 64 + fq * 4;
#pragma unroll
    for (int dt = 0; dt < 4; ++dt) {
        u32x2 w; w.x = pk_bf16(o[dt][0] * inv, o[dt][1] * inv); w.y = pk_bf16(o[dt][2] * inv, o[dt][3] * inv);
        *(u32x2*)(op + dt * 16) = w;
    }
}

DEV void attn_phase(const Params& p, char* smem, bool even, unsigned* ctr) {
    int* smi = (int*)(smem + AT_MISC);
    const int tid = TID;
    for (;;) {
        __syncthreads();
        if (tid == 0) smi[74] = (int)__hip_atomic_fetch_add(ctr, 1u, __ATOMIC_RELAXED, __HIP_MEMORY_SCOPE_AGENT);
        __syncthreads();
        const int it = smi[74];
        if (it >= 32 * 128) break;
        const int qt = 31 - (it >> 7), bh = it & 127, b = bh >> 4, h16 = bh & 15;
        if (even) { if (h16 < 8) attn_item<AT_FOX>(p, smem, b, h16, qt); else attn_item<AT_SB>(p, smem, b, h16 - 8, qt); }
        else { if (h16 < 8) attn_item<AT_MOBA>(p, smem, b, h16, qt); else attn_item<AT_MLA>(p, smem, b, h16 - 8, qt); }
    }
}

DEV void gsync(unsigned* ctr, unsigned& target) {
    __builtin_amdgcn_fence(__ATOMIC_RELEASE, "agent");
    __syncthreads();
    target += gridDim.x;
    if (threadIdx.x == 0) {
        __hip_atomic_fetch_add(ctr, 1u, __ATOMIC_RELEASE, __HIP_MEMORY_SCOPE_AGENT);
        while (__hip_atomic_load(ctr, __ATOMIC_ACQUIRE, __HIP_MEMORY_SCOPE_AGENT) < target) __builtin_amdgcn_s_sleep(4);
    }
    __syncthreads();
    __builtin_amdgcn_fence(__ATOMIC_ACQUIRE, "agent");
}

enum { OP_NORM_MIX = 0, OP_GEMM_IN, OP_EPOST, OP_OPOST1, OP_GEMM_QB, OP_GEMM_KVB, OP_GATE, OP_MLAPOST, OP_ATTN, OP_GEMM_OUT, OP_NORM_FFN, OP_GEMM_GU, OP_GEMM_DN };

__global__ void __launch_bounds__(512) fwd_megakernel(Params p) {
    extern __shared__ __attribute__((aligned(16))) char smem[];
    cg::grid_group grid = cg::this_grid();
    char* ws = p.ws;
    unsigned* bar = (unsigned*)(ws + OFF_BAR);
    unsigned btarget = 0;
    grid.sync();
    prologue(p, smem);
    gsync(bar, btarget);
    for (int gs = 0; gs < 40; ++gs) {
        {
            const int gq = opq_s(gs);
#ifdef DBG_STEPS
            if (gq >= DBG_STEPS) break;
#endif
            const int pair = gq / 20, rr20 = gq - pair * 20;
            const bool even = rr20 < 8;
            const int step = even ? rr20 : rr20 - 8;
            const int layer = pair * 2 + (even ? 0 : 1), li = pair;
            const float* xin = layer == 0 ? p.x : p.out;
            int op; bool sync = true;
            if (even) {
                switch (step) { case 0: op = OP_NORM_MIX; break; case 1: op = OP_GEMM_IN; break; case 2: op = OP_EPOST; break; case 3: op = OP_ATTN; break;
                                case 4: op = OP_GEMM_OUT; break; case 5: op = OP_NORM_FFN; break; case 6: op = OP_GEMM_GU; break; default: op = OP_GEMM_DN; break; }
            } else {
                switch (step) { case 0: op = OP_NORM_MIX; break; case 1: op = OP_GEMM_IN; break; case 2: op = OP_OPOST1; break; case 3: op = OP_GEMM_QB; break;
                                case 4: op = OP_GEMM_KVB; break; case 5: op = OP_GATE; break; case 6: op = OP_MLAPOST; break; case 7: op = OP_ATTN; break;
                                case 8: op = OP_GEMM_OUT; break; case 9: op = OP_NORM_FFN; break; case 10: op = OP_GEMM_GU; break; default: op = OP_GEMM_DN; break; }
            }
            if (op == OP_GEMM_QB || op == OP_GEMM_KVB) sync = false;
            bool jp = false, jv = false, jr = false, jg = false;
            const bf16_t *pA = nullptr, *pB = nullptr, *vA = nullptr, *vB = nullptr, *rA = nullptr, *rB = nullptr;
            int pldA = 0, pN = 0, pK = 0, vM = 0, vldB = 0, vK = 0, rK = 0, vhead = 0;
            EpiPlain eP{nullptr, 0, 0}; const float* rxin = nullptr;
            switch (op) {
            case OP_NORM_MIX: norm_phase(xin, (even ? p.ev_norm : p.od_norm) + li * DM, (bf16_t*)(ws + OFF_HM), even ? p.ev_w_in + (size_t)li * 1024 * 3080 : nullptr, (float*)(ws + OFF_FA), smem); break;
            case OP_NORM_FFN: norm_phase(p.out, p.ffn_norm + layer * DM, (bf16_t*)(ws + OFF_HM), nullptr, nullptr, smem); break;
            case OP_EPOST: even_post(p, li, smem); break;
            case OP_OPOST1: odd_post1(p, li, smem); break;
            case OP_GATE: moba_gate(p); break;
            case OP_MLAPOST: mla_post(p, li); break;
            case OP_ATTN: attn_phase(p, smem, even, bar + 16 + layer); break;
            case OP_GEMM_IN:
                jp = jv = true; pA = (const bf16_t*)(ws + OFF_HM); pldA = 1024; pK = 1024; vB = pA; vldB = 1024; vK = 1024; vhead = 0;
                if (even) { pB = (const bf16_t*)(ws + OFF_EVIN) + li * SZ_EVIN; pN = 2048; eP = EpiPlain{(bf16_t*)(ws + OFF_EB), 2048, 0}; vA = pB + (size_t)2048 * 1024; vM = 1024; }
                else { pB = (const bf16_t*)(ws + OFF_ODIN) + li * SZ_ODIN; pN = 1536; eP = EpiPlain{(bf16_t*)(ws + OFF_EB), 1536, 0}; vA = pB + (size_t)1536 * 1024; vM = 512; }
                break;
            case OP_GEMM_QB:
                jp = true; pA = (const bf16_t*)(ws + OFF_EB) + 1024; pldA = 1536; pK = 256; pB = (const bf16_t*)(ws + OFF_QB) + li * SZ_QB; pN = 768; eP = EpiPlain{(bf16_t*)(ws + OFF_QD), 768, 0};
                break;
            case OP_GEMM_KVB:
                jp = jv = true; pA = (const bf16_t*)(ws + OFF_EB) + 1280; pldA = 1536; pK = 128; pB = (const bf16_t*)(ws + OFF_KVB) + li * SZ_KVB; pN = 512; eP = EpiPlain{(bf16_t*)(ws + OFF_KD), 768, 1};
                vA = pB + (size_t)512 * 128; vM = 512; vB = pA; vldB = 1536; vK = 128; vhead = 8;
                break;
            case OP_GEMM_OUT:
                jr = true; rA = (const bf16_t*)(ws + OFF_HM); rK = 1024; rB = (const bf16_t*)(ws + (even ? OFF_EVOUT : OFF_ODOUT)) + li * SZ_OUT; rxin = xin;
                break;
            case OP_GEMM_GU: jg = true; break;
            default:
                jr = true; rA = (const bf16_t*)(ws + OFF_ACT); rK = DFF; rB = (const bf16_t*)(ws + OFF_DN) + layer * SZ_DN; rxin = p.out;
                break;
            }
            if (jp) run_gemm(smem, pA, pldA, M_TOK, pB, pK, pN, pK, eP);
            if (jv) run_gemm(smem, vA, vK, vM, vB, vldB, M_TOK, vK, EpiVT{(bf16_t*)(ws + OFF_VT), vhead});
            if (jr) run_gemm(smem, rA, rK, M_TOK, rB, rK, 1024, rK, EpiResid{rxin, p.out});
            if (jg) run_gemm(smem, (const bf16_t*)(ws + OFF_HM), 1024, M_TOK, (const bf16_t*)(ws + OFF_GU) + layer * SZ_GU, 1024, 5632, 1024, EpiSwiglu{(bf16_t*)(ws + OFF_ACT)});
            if (sync) gsync(bar, btarget);
        }
    }
#ifdef DBG_STEPS
    gsync(bar, btarget);
    {
        const size_t n = (size_t)M_TOK * 1024;
        const bf16_t* b0 = (const bf16_t*)(ws + OFF_HM);
        const bf16_t* b1 = (const bf16_t*)(ws + DBG_OFF1);
        const bf16_t* b2 = (const bf16_t*)(ws + DBG_OFF2);
        const bf16_t* b3 = (const bf16_t*)(ws + OFF_EB + (size_t)M_TOK * 1024 * 2);
        for (size_t i = (size_t)blockIdx.x * NT + threadIdx.x; i < n; i += (size_t)gridDim.x * NT) {
            float v = bf_lo(b0[i]) + bf_lo(b1[i]) + bf_lo(b2[i]) + bf_lo(b3[i]);
            if (DBG_STEPS >= 5) v += p.out[i];
            p.out[i] = v;
        }
    }
#endif
}

extern "C" void kernel_launch(void* const* d_in, const int* in_sizes, int n_in, void* d_out, int out_size, void* d_ws, size_t ws_size,
                              hipStream_t stream) {
    if (ws_size < OFF_END + 256) return;
    static int grid_blocks = 0;
    if (!grid_blocks) {
        int dev = 0, cus = 0, per_cu = 0;
        hipGetDevice(&dev);
        hipDeviceGetAttribute(&cus, hipDeviceAttributeMultiprocessorCount, dev);
        hipFuncSetAttribute((const void*)fwd_megakernel, hipFuncAttributeMaxDynamicSharedMemorySize, SMEM_BYTES);
        hipOccupancyMaxActiveBlocksPerMultiprocessor(&per_cu, fwd_megakernel, NT, SMEM_BYTES);
        if (per_cu > 1) per_cu = 1;
        if (per_cu < 1) per_cu = 1;
        grid_blocks = cus * per_cu;
    }
    Params p{};
    p.x = (const float*)d_in[0]; p.ffn_norm = (const float*)d_in[1]; p.w_gu = (const float*)d_in[2]; p.w_dn = (const float*)d_in[3];
    p.rel_bias = (const float*)d_in[4]; p.ev_norm = (const float*)d_in[5]; p.ev_w_in = (const float*)d_in[6]; p.ev_fb = (const float*)d_in[7];
    p.ev_qn = (const float*)d_in[8]; p.ev_kn = (const float*)d_in[9]; p.ev_w_out = (const float*)d_in[10]; p.od_norm = (const float*)d_in[11];
    p.od_w_in = (const float*)d_in[12]; p.od_mqn = (const float*)d_in[13]; p.od_mkn = (const float*)d_in[14]; p.od_qan = (const float*)d_in[15];
    p.od_wqb = (const float*)d_in[16]; p.od_kvan = (const float*)d_in[17]; p.od_wkvb = (const float*)d_in[18]; p.od_lqn = (const float*)d_in[19];
    p.od_lkn = (const float*)d_in[20]; p.od_w_out = (const float*)d_in[21];
    p.out = (float*)d_out; p.ws = (char*)d_ws;
    hipMemsetAsync((char*)d_ws + OFF_BAR, 0, 256, stream);
    void* args[] = {&p};
    hipError_t e = hipLaunchCooperativeKernel((void*)fwd_megakernel, dim3(grid_blocks), dim3(NT), args, SMEM_BYTES, stream);
    if (e != hipSuccess) fprintf(stderr, "cooperative launch failed: %s (grid %d)\n", hipGetErrorString(e), grid_blocks);
}
```

```cpp
#include <hip/hip_runtime.h>
#include <hip/hip_cooperative_groups.h>
#include <cstdio>
#include <cstdint>
namespace cg = cooperative_groups;

typedef unsigned short bf16_t;
typedef short bf16x8 __attribute__((ext_vector_type(8)));
typedef float f32x4 __attribute__((ext_vector_type(4)));
typedef unsigned u32x4 __attribute__((ext_vector_type(4)));
typedef unsigned u32x2 __attribute__((ext_vector_type(2)));

#define DEV __device__ __forceinline__
#define NO_SB_EXIT 0
#define DBG_REP_ATTN 1
#define DBG_REP_GU 1
#define DBG_REP_SMALL 1
#define DBG_EXTRA_SYNC 0
#define DBG_SKIP_SB 0
#define DBG_NOSHFL 0
#define DBG_SKIP_FOX 0
#define DBG_OFF1 OFF_EB
#define DBG_OFF2 OFF_VT

constexpr int M_TOK = 32768, SEQ = 4096, DM = 1024, DFF = 2816;
constexpr float EPS = 1e-6f;
constexpr float LOG2E = 1.4426950408889634f;

constexpr size_t SZ_EVIN = 3200ull * 1024, SZ_ODIN = 2048ull * 1024, SZ_OUT = 1024ull * 1024, SZ_GU = 5632ull * 1024,
                 SZ_DN = 1024ull * 2816, SZ_QB = 768ull * 256, SZ_KVB = 1024ull * 128;
constexpr size_t OFF_EVIN = 0;
constexpr size_t OFF_ODIN = OFF_EVIN + 2 * SZ_EVIN * 2;
constexpr size_t OFF_EVOUT = OFF_ODIN + 2 * SZ_ODIN * 2;
constexpr size_t OFF_ODOUT = OFF_EVOUT + 2 * SZ_OUT * 2;
constexpr size_t OFF_GU = OFF_ODOUT + 2 * SZ_OUT * 2;
constexpr size_t OFF_DN = OFF_GU + 4 * SZ_GU * 2;
constexpr size_t OFF_QB = OFF_DN + 4 * SZ_DN * 2;
constexpr size_t OFF_KVB = OFF_QB + 2 * SZ_QB * 2;
constexpr size_t OFF_HM = OFF_KVB + 2 * SZ_KVB * 2;
constexpr size_t OFF_EB = OFF_HM + (size_t)M_TOK * 1024 * 2;
constexpr size_t OFF_VT = OFF_EB + (size_t)M_TOK * 2048 * 2;
constexpr size_t OFF_QD = OFF_VT + (size_t)M_TOK * 1024 * 2;
constexpr size_t OFF_KD = OFF_QD + (size_t)M_TOK * 768 * 2;
constexpr size_t OFF_FA = OFF_KD + (size_t)M_TOK * 768 * 2;
constexpr size_t OFF_CDEC = OFF_FA + (size_t)M_TOK * 8 * 4;
constexpr size_t OFF_KMEAN = OFF_CDEC + 64ull * 4096 * 4;
constexpr size_t OFF_SEL = OFF_KMEAN + 8ull * 8 * 16 * 64 * 4;
constexpr size_t OFF_BTAB = OFF_SEL + 64ull * 4096 * 4;
constexpr size_t OFF_ROPE = OFF_BTAB + 8ull * 128 * 4;
constexpr size_t OFF_END = OFF_ROPE + 2ull * 4096 * 16 * 4;
constexpr size_t OFF_BAR = OFF_END;
constexpr size_t OFF_ACT = OFF_EB;
static_assert((size_t)M_TOK * DFF * 2 <= (size_t)M_TOK * 3072 * 2, "ACT overlay");

constexpr int SMEM_BYTES = 131072;
constexpr int NT = 512;

struct Params {
    const float* x; const float* ffn_norm; const float* w_gu; const float* w_dn; const float* rel_bias;
    const float* ev_norm; const float* ev_w_in; const float* ev_fb; const float* ev_qn; const float* ev_kn; const float* ev_w_out;
    const float* od_norm; const float* od_w_in; const float* od_mqn; const float* od_mkn; const float* od_qan; const float* od_wqb;
    const float* od_kvan; const float* od_wkvb; const float* od_lqn; const float* od_lkn; const float* od_w_out;
    float* out; char* ws;
};

typedef __bf16 bf16v2_t __attribute__((ext_vector_type(2)));
typedef float f32x2_t __attribute__((ext_vector_type(2)));
DEV unsigned pk_bf16(float lo, float hi) { f32x2_t v = {lo, hi}; bf16v2_t b = __builtin_convertvector(v, bf16v2_t); return __builtin_bit_cast(unsigned, b); }
DEV int opq_v(int x) { asm volatile("" : "+v"(x)); return x; }
DEV int opq_s(int x) { asm volatile("" : "+s"(x)); return x; }
#define TID opq_v((int)threadIdx.x)
#define BID opq_s((int)blockIdx.x)
DEV float bf_lo(unsigned u) { return __uint_as_float(u << 16); }
DEV float bf_hi(unsigned u) { return __uint_as_float(u & 0xffff0000u); }

enum { WM_ID = 0, WM_EVIN, WM_ODIN, WM_GU, WM_KVB };
DEV int srcmap(int mode, int n) {
    switch (mode) {
    case WM_EVIN:
        if (n < 1024) return n;
        if (n < 1536) return 1544 + (n - 1024);
        if (n < 2048) return 2056 + (n - 1536);
        if (n < 2560) return 1024 + (n - 2048);
        if (n < 3072) return 2568 + (n - 2560);
        return -1;
    case WM_ODIN:
        if (n < 1024) return n;
        if (n < 1280) return 1536 + (n - 1024);
        if (n < 1408) return 1792 + (n - 1280);
        if (n < 1440) return 1920 + (n - 1408);
        if (n < 1536) return -1;
        return 1024 + (n - 1536);
    case WM_GU: { const int pn = n >> 8, bj = (n >> 7) & 1, t = n & 127; return bj * 2816 + 128 * pn + t; }
    case WM_KVB: { if (n < 512) return (n >> 6) * 128 + (n & 63); int m = n - 512; return (m >> 6) * 128 + 64 + (m & 63); }
    default: return n;
    }
}

DEV void convert_matrix(const float* __restrict__ W, bf16_t* __restrict__ Bt, int K, int N, int Np, int mode, float* lds) {
    const int tid = TID;
    const int nkt = K >> 6, ntiles = (Np >> 6) * nkt;
    for (int t = BID; t < ntiles; t += gridDim.x) {
        const int k0 = (t % nkt) << 6, n0 = (t / nkt) << 6;
        const int nn = tid & 63, src = srcmap(mode, n0 + nn);
        __syncthreads();
#pragma unroll 4
        for (int i = 0; i < 8; ++i) {
            const int kk = (tid >> 6) + 8 * i;
            lds[nn * 65 + kk] = src >= 0 ? W[(size_t)(k0 + kk) * N + src] : 0.f;
        }
        __syncthreads();
        const int r = tid >> 3, c = tid & 7;
        const float* lp = lds + r * 65 + c * 8;
        u32x4 a;
        a.x = pk_bf16(lp[0], lp[1]); a.y = pk_bf16(lp[2], lp[3]); a.z = pk_bf16(lp[4], lp[5]); a.w = pk_bf16(lp[6], lp[7]);
        *(u32x4*)(Bt + (size_t)(n0 + r) * K + k0 + c * 8) = a;
    }
}

DEV void prologue(const Params& p, char* smem) {
    float* lds = (float*)smem;
    char* ws = p.ws;
    for (int i = 0; i < 2; ++i) {
        convert_matrix(p.ev_w_in + (size_t)i * 1024 * 3080, (bf16_t*)(ws + OFF_EVIN) + i * SZ_EVIN, 1024, 3080, 3072, WM_EVIN, lds);
        convert_matrix(p.od_w_in + (size_t)i * 1024 * 1952, (bf16_t*)(ws + OFF_ODIN) + i * SZ_ODIN, 1024, 1952, 2048, WM_ODIN, lds);
        convert_matrix(p.ev_w_out + (size_t)i * 1024 * 1024, (bf16_t*)(ws + OFF_EVOUT) + i * SZ_OUT, 1024, 1024, 1024, WM_ID, lds);
        convert_matrix(p.od_w_out + (size_t)i * 1024 * 1024, (bf16_t*)(ws + OFF_ODOUT) + i * SZ_OUT, 1024, 1024, 1024, WM_ID, lds);
        convert_matrix(p.od_wqb + (size_t)i * 256 * 768, (bf16_t*)(ws + OFF_QB) + i * SZ_QB, 256, 768, 768, WM_ID, lds);
        convert_matrix(p.od_wkvb + (size_t)i * 128 * 1024, (bf16_t*)(ws + OFF_KVB) + i * SZ_KVB, 128, 1024, 1024, WM_KVB, lds);
    }
    for (int l = 0; l < 4; ++l) {
        convert_matrix(p.w_gu + (size_t)l * 1024 * 5632, (bf16_t*)(ws + OFF_GU) + l * SZ_GU, 1024, 5632, 5632, WM_GU, lds);
        convert_matrix(p.w_dn + (size_t)l * 2816 * 1024, (bf16_t*)(ws + OFF_DN) + l * SZ_DN, 2816, 1024, 1024, WM_ID, lds);
    }
    const int gt = BID * blockDim.x + TID, gn = gridDim.x * blockDim.x;
    float* btab = (float*)(ws + OFF_BTAB);
    for (int i = gt; i < 8 * 128; i += gn) {
        const int h = i >> 7, n = i & 127;
        int bucket;
        if (n < 16) bucket = n;
        else { const float v = logf((float)n / 16.0f) / 2.0794415416798357f * 16.0f; bucket = 16 + (int)v; if (bucket > 31) bucket = 31; }
        btab[i] = p.rel_bias[h * 32 + bucket] * LOG2E;
    }
    float* rope = (float*)(ws + OFF_ROPE);
    for (int i = gt; i < 4096 * 16; i += gn) {
        const int pos = i >> 4, f = i & 15;
        const float inv = powf(10000.0f, -(float)f / 16.0f);
        const float ang = (float)pos * inv;
        const double a = (double)ang;
        const double r = a - 6.283185307179586476925 * rint(a * 0.15915494309189533577);
        const float fr_ = (float)(r * 0.15915494309189533577);
        rope[i] = __builtin_amdgcn_cosf(fr_);
        rope[4096 * 16 + i] = __builtin_amdgcn_sinf(fr_);
    }
}

DEV void norm_phase(const float* __restrict__ x, const float* __restrict__ gain, bf16_t* __restrict__ h, const float* __restrict__ wfa, float* __restrict__ FA, char* smem) {
    const int tid = TID, lane = tid & 63, wv = (BID * NT + tid) >> 6, nw = (gridDim.x * NT) >> 6;
    float* wl = (float*)smem;
    if (wfa) {
        __syncthreads();
        for (int i = tid; i < 8192; i += NT) { const int k = i >> 3, j = i & 7; wl[j * 1024 + k] = wfa[(size_t)k * 3080 + 1536 + j]; }
        __syncthreads();
    }
    f32x4 g[4];
#pragma unroll
    for (int i = 0; i < 4; ++i) g[i] = *(const f32x4*)(gain + 4 * (lane + 64 * i));
    for (int row = wv; row < M_TOK; row += nw) {
        const float* xr = x + (size_t)row * DM;
        f32x4 v[4]; float ss = 0.f;
#pragma unroll
        for (int i = 0; i < 4; ++i) { v[i] = *(const f32x4*)(xr + 4 * (lane + 64 * i)); ss += v[i][0] * v[i][0] + v[i][1] * v[i][1] + v[i][2] * v[i][2] + v[i][3] * v[i][3]; }
#pragma unroll
        for (int o = 32; o > 0; o >>= 1) ss += __shfl_xor(ss, o);
        const float rstd = rsqrtf(ss * (1.0f / DM) + EPS);
        bf16_t* hr = h + (size_t)row * DM;
#pragma unroll
        for (int i = 0; i < 4; ++i) {
            v[i] = v[i] * rstd * g[i];
            u32x2 o; o.x = pk_bf16(v[i][0], v[i][1]); o.y = pk_bf16(v[i][2], v[i][3]);
            *(u32x2*)(hr + 4 * (lane + 64 * i)) = o;
        }
        if (wfa) {
            float fs[8];
#pragma unroll
            for (int j = 0; j < 8; ++j) {
                float a = 0.f;
#pragma unroll
                for (int i = 0; i < 4; ++i) { const f32x4 w = *(const f32x4*)(wl + j * 1024 + 4 * (lane + 64 * i)); a += v[i][0] * w[0] + v[i][1] * w[1] + v[i][2] * w[2] + v[i][3] * w[3]; }
#pragma unroll
                for (int o = 32; o > 0; o >>= 1) a += __shfl_xor(a, o);
                fs[j] = a;
            }
            if (lane == 0) { *(f32x4*)(FA + (size_t)row * 8) = (f32x4){fs[0], fs[1], fs[2], fs[3]}; *(f32x4*)(FA + (size_t)row * 8 + 4) = (f32x4){fs[4], fs[5], fs[6], fs[7]}; }
        }
    }
}

namespace pg8 {
#define PG8_LAS __attribute__((address_space(3)))
constexpr int BM = 256, BK = 64, HALF = 128, HTB = HALF * BK * 2, STAGE_BYTES = 8 * HTB, NXCD = 8, WGM = 8;
DEV int lds_byte(int r, int c) { const int st = (r >> 4) * 2 + (c >> 5), rr = r & 15, cc = c & 31, ob = rr * 64 + cc * 2; return st * 1024 + (ob ^ (((ob >> 9) & 1) << 5)); }
DEV void stage_rc(int b, int& R, int& C) { const int st = b / 1024, sb = b % 1024, swz = sb ^ (((sb >> 9) & 1) << 5); R = (st >> 1) * 16 + swz / 64; C = (st & 1) * 32 + (swz % 64) / 2; }
DEV int perm32(int rho) { const int n = rho >> 4, i = rho & 15; return 8 * (i >> 2) + 4 * n + (i & 3); }
struct Unit { int pm, pn; };
struct Gemm { const bf16_t* A; const bf16_t* Bt; int M, N, K, ldA, ldB; };
struct StaticOrder {
    int nM, nN, nwg, G, c;
    DEV void init(int M, int N, int G_, int c_) { nM = M / BM; nN = N / BM; nwg = nM * nN; G = G_; c = c_; }
    DEV bool next(int i, Unit& u) const {
        const long L = (long)i * G + c; if (L >= nwg) return false;
        int wgid = (int)L; { const int q = nwg / NXCD, r = nwg % NXCD, xcd = wgid % NXCD, off = wgid / NXCD; wgid = (xcd < r ? xcd * (q + 1) : r * (q + 1) + (xcd - r) * q) + off; }
        const int nig = WGM * nN, gid = wgid / nig, fm = gid * WGM, gsz = (nM - fm) < WGM ? (nM - fm) : WGM;
        u.pm = fm + ((wgid % nig) % gsz); u.pn = (wgid % nig) / gsz; return true;
    }
};
template <class Epi>
DEV void gemm_phase(PG8_LAS unsigned char* lds, const Gemm g, const StaticOrder& S, const Epi& E) {
    const int tid = TID, wid = __builtin_amdgcn_readfirstlane(tid >> 6), lane = tid & 63, wr = wid >> 2, wc = wid & 3, fr = lane & 15, fq = lane >> 4;
    const int K = g.K, nt = K / BK;
    unsigned voffA[2], voffB[2];
#pragma unroll
    for (int i = 0; i < 2; ++i) { int R, C; stage_rc(tid * 16 + i * 8192, R, C); const int Rb = (R & ~31) + perm32(R & 31);
        voffA[i] = (unsigned)(R * g.ldA + C) * 2u; voffB[i] = (unsigned)(Rb * g.ldB + C) * 2u; }
    const size_t kstep = (size_t)(BK * 2);
    const size_t hstepA = (size_t)HALF * g.ldA * 2, hstepB = (size_t)HALF * g.ldB * 2, tstepA = 2 * hstepA, tstepB = 2 * hstepB;
    const unsigned ldsw = (unsigned)wid * 1024u;
    const int aoff = lds_byte(wr * 64 + fr, fq * 8), boff = lds_byte(wc * 32 + fr, fq * 8);
#define PG8_SA(b, h) (((b) * 2 + (h)) * HTB)
#define PG8_SB(b, h) ((4 + (b) * 2 + (h)) * HTB)
#define PG8_STAGE(bufoff, gbase, voff) do { _Pragma("unroll") for (int _i = 0; _i < 2; ++_i) \
        __builtin_amdgcn_global_load_lds((const unsigned*)((const char*)(gbase) + (voff)[_i]), (PG8_LAS unsigned*)(lds + (bufoff) + ldsw + _i * 8192), 16, 0, 0); } while (0)
#define PG8_LDA(dst, b, h) do { _Pragma("unroll") for (int m = 0; m < 4; ++m) _Pragma("unroll") for (int k = 0; k < 2; ++k) dst[m][k] = *(const PG8_LAS bf16x8*)(lds + PG8_SA(b, h) + aoff + m * 2048 + k * 1024); } while (0)
#define PG8_LDB(dst, b, h) do { _Pragma("unroll") for (int n = 0; n < 2; ++n) _Pragma("unroll") for (int k = 0; k < 2; ++k) dst[n][k] = *(const PG8_LAS bf16x8*)(lds + PG8_SB(b, h) + boff + n * 2048 + k * 1024); } while (0)
#define PG8_MMA(ai, bj, At, Bt) do { __builtin_amdgcn_s_setprio(1); _Pragma("unroll") for (int m = 0; m < 4; ++m) _Pragma("unroll") for (int n = 0; n < 2; ++n) _Pragma("unroll") for (int k = 0; k < 2; ++k) \
        acc[ai][bj][m][n] = __builtin_amdgcn_mfma_f32_16x16x32_bf16(Bt[n][k], At[m][k], acc[ai][bj][m][n], 0, 0, 0); __builtin_amdgcn_s_setprio(0); } while (0)
#define PG8_WAIT_V(n) asm volatile("s_waitcnt vmcnt(" #n ")" ::: "memory")
#define PG8_WAIT_L(n) asm volatile("s_waitcnt lgkmcnt(" #n ")" ::: "memory")
#define PG8_BAR __builtin_amdgcn_s_barrier()
#define PG8_SCHED __builtin_amdgcn_sched_barrier(0)
    Unit cur, nxt; int ui = 0;
    if (!S.next(0, cur)) return;
    f32x4 acc[2][2][4][2];
#pragma unroll
    for (int a = 0; a < 2; ++a)
#pragma unroll
        for (int b = 0; b < 2; ++b)
#pragma unroll
            for (int m = 0; m < 4; ++m)
#pragma unroll
                for (int n = 0; n < 2; ++n) acc[a][b][m][n] = (f32x4){0.f, 0.f, 0.f, 0.f};
    bf16x8 At[4][2], B0[2][2], B1[2][2];
    const char* cA = (const char*)g.A + (size_t)cur.pm * tstepA; const char* cB = (const char*)g.Bt + (size_t)cur.pn * tstepB;
    PG8_STAGE(PG8_SB(0, 0), cB, voffB); PG8_STAGE(PG8_SB(0, 1), cB + hstepB, voffB); PG8_STAGE(PG8_SA(0, 0), cA, voffA); PG8_STAGE(PG8_SA(0, 1), cA + hstepA, voffA);
    if (wr == 1) PG8_BAR;
    PG8_WAIT_V(2); PG8_BAR;
    PG8_STAGE(PG8_SB(1, 0), cB + kstep, voffB); PG8_STAGE(PG8_SA(1, 0), cA + kstep, voffA); PG8_STAGE(PG8_SB(1, 1), cB + hstepB + kstep, voffB);
    PG8_WAIT_V(6); PG8_BAR;
    for (;;) {
        const bool has_next = S.next(ui + 1, nxt);
        const char* nA = has_next ? (const char*)g.A + (size_t)nxt.pm * tstepA : cA; const char* nB = has_next ? (const char*)g.Bt + (size_t)nxt.pn * tstepB : cB;
        for (int t = 0; t < nt; t += 2) {
            const bool last = (t == nt - 2);
            const char* a1 = cA + (size_t)(t + 1) * kstep;
            const char* a2 = last ? nA : cA + (size_t)(t + 2) * kstep; const char* b2 = last ? nB : cB + (size_t)(t + 2) * kstep;
            const char* a3 = a2 + kstep; const char* b3 = b2 + kstep;
            PG8_LDB(B0, 0, 0); PG8_LDB(B1, 0, 1); PG8_SCHED; PG8_LDA(At, 0, 0); PG8_STAGE(PG8_SA(1, 1), a1 + hstepA, voffA);
            PG8_WAIT_V(8); PG8_WAIT_L(0); PG8_BAR; PG8_MMA(0, 0, At, B0); PG8_MMA(0, 1, At, B1); PG8_BAR; PG8_SCHED;
            PG8_LDA(At, 0, 1); PG8_STAGE(PG8_SB(0, 0), b2, voffB); PG8_STAGE(PG8_SB(0, 1), b2 + hstepB, voffB); PG8_STAGE(PG8_SA(0, 0), a2, voffA);
            PG8_WAIT_V(8); PG8_WAIT_L(0); PG8_BAR; PG8_MMA(1, 0, At, B0); PG8_MMA(1, 1, At, B1); PG8_BAR; PG8_SCHED;
            PG8_LDB(B0, 1, 0); PG8_LDB(B1, 1, 1); PG8_SCHED; PG8_LDA(At, 1, 0); PG8_STAGE(PG8_SA(0, 1), a2 + hstepA, voffA);
            PG8_WAIT_V(8); PG8_WAIT_L(0); PG8_BAR; PG8_MMA(0, 0, At, B0); PG8_MMA(0, 1, At, B1); PG8_BAR; PG8_SCHED;
            PG8_LDA(At, 1, 1); PG8_STAGE(PG8_SB(1, 0), b3, voffB); PG8_STAGE(PG8_SB(1, 1), b3 + hstepB, voffB); PG8_STAGE(PG8_SA(1, 0), a3, voffA);
            PG8_WAIT_V(8); PG8_WAIT_L(0); PG8_BAR; PG8_MMA(1, 0, At, B0); PG8_MMA(1, 1, At, B1); PG8_BAR; PG8_SCHED;
        }
        if (wr == 0) PG8_BAR;
        E(acc, cur, wr, wc, fr, fq);
        if (!has_next) break;
#pragma unroll
        for (int a = 0; a < 2; ++a)
#pragma unroll
            for (int b = 0; b < 2; ++b)
#pragma unroll
                for (int m = 0; m < 4; ++m)
#pragma unroll
                    for (int n = 0; n < 2; ++n) acc[a][b][m][n] = (f32x4){0.f, 0.f, 0.f, 0.f};
        cur = nxt; cA = nA; cB = nB; ++ui;
        if (wr == 1) PG8_BAR;
    }
    PG8_WAIT_V(0);
    PG8_BAR;
#undef PG8_SA
#undef PG8_SB
#undef PG8_STAGE
#undef PG8_LDA
#undef PG8_LDB
#undef PG8_MMA
#undef PG8_WAIT_V
#undef PG8_WAIT_L
#undef PG8_BAR
#undef PG8_SCHED
}
}

typedef f32x4 AccT[2][2][4][2];
DEV u32x4 pack8(const f32x4& a, const f32x4& b) { u32x4 w; w.x = pk_bf16(a[0], a[1]); w.y = pk_bf16(a[2], a[3]); w.z = pk_bf16(b[0], b[1]); w.w = pk_bf16(b[2], b[3]); return w; }

struct EpiPlain {
    bf16_t* C; int ldc; int kd;
    DEV void operator()(const AccT& acc, const pg8::Unit& u, int wr, int wc, int fr, int fq) const {
        const int row0 = u.pm * 256 + wr * 64 + fr, col0 = u.pn * 256 + wc * 32 + 8 * fq;
#pragma unroll
        for (int ai = 0; ai < 2; ++ai)
#pragma unroll
            for (int m = 0; m < 4; ++m) {
                bf16_t* rowp = C + (size_t)(row0 + ai * 128 + m * 16) * ldc;
#pragma unroll
                for (int bj = 0; bj < 2; ++bj) { int col = col0 + bj * 128; if (kd) col = (col >> 6) * 96 + (col & 63);
                    *(u32x4*)(rowp + col) = pack8(acc[ai][bj][m][0], acc[ai][bj][m][1]); }
            }
    }
};
struct EpiResid {
    const float* xin; float* xout;
    DEV void operator()(const AccT& acc, const pg8::Unit& u, int wr, int wc, int fr, int fq) const {
        const int row0 = u.pm * 256 + wr * 64 + fr, col0 = u.pn * 256 + wc * 32 + 8 * fq;
#pragma unroll
        for (int ai = 0; ai < 2; ++ai)
#pragma unroll
            for (int m = 0; m < 4; ++m) {
                const size_t ro = (size_t)(row0 + ai * 128 + m * 16) * DM;
#pragma unroll
                for (int bj = 0; bj < 2; ++bj) { const size_t o = ro + col0 + bj * 128;
                    const f32x4 x0 = *(const f32x4*)(xin + o), x1 = *(const f32x4*)(xin + o + 4);
                    *(f32x4*)(xout + o) = x0 + acc[ai][bj][m][0]; *(f32x4*)(xout + o + 4) = x1 + acc[ai][bj][m][1]; }
            }
    }
};
struct EpiSwiglu {
    bf16_t* ACT;
    DEV void operator()(const AccT& acc, const pg8::Unit& u, int wr, int wc, int fr, int fq) const {
        const int row0 = u.pm * 256 + wr * 64 + fr, col0 = u.pn * 128 + wc * 32 + 8 * fq;
#pragma unroll
        for (int ai = 0; ai < 2; ++ai)
#pragma unroll
            for (int m = 0; m < 4; ++m) {
                f32x4 o[2];
#pragma unroll
                for (int n = 0; n < 2; ++n)
#pragma unroll
                    for (int j = 0; j < 4; ++j) { const float gv = acc[ai][0][m][n][j], uv = acc[ai][1][m][n][j]; o[n][j] = gv / (1.0f + __expf(-gv)) * uv; }
                *(u32x4*)(ACT + (size_t)(row0 + ai * 128 + m * 16) * DFF + col0) = pack8(o[0], o[1]);
            }
    }
};
struct EpiVT {
    bf16_t* VT; int head_base;
    DEV void operator()(const AccT& acc, const pg8::Unit& u, int wr, int wc, int fr, int fq) const {
        const int r0 = u.pm * 256 + wr * 64 + fr, c0 = u.pn * 256 + wc * 32 + 8 * fq;
#pragma unroll
        for (int ai = 0; ai < 2; ++ai)
#pragma unroll
            for (int m = 0; m < 4; ++m) {
                const int r = r0 + ai * 128 + m * 16, head = head_base + (r >> 6), d = r & 63;
#pragma unroll
                for (int bj = 0; bj < 2; ++bj) { const int c = c0 + bj * 128, b = c >> 12, sq = c & 4095;
                    *(u32x4*)(VT + ((size_t)((b * 16 + head) * 64 + d)) * 4096 + sq) = pack8(acc[ai][bj][m][0], acc[ai][bj][m][1]); }
            }
    }
};
template <class Epi>
DEV void run_gemm(char* smem, const bf16_t* A, int ldA, int M, const bf16_t* Bt, int ldB, int N, int K, const Epi& E) {
    __syncthreads();
    pg8::Gemm g{A, Bt, M, N, K, ldA, ldB}; pg8::StaticOrder S; S.init(M, N, (int)gridDim.x, BID);
    pg8::gemm_phase<Epi>((PG8_LAS unsigned char*)smem, g, S, E);
    __syncthreads();
}

template <int LPR, bool MEAN>
DEV void rownorm_block(bf16_t* buf, int ld, int col0, const float* __restrict__ gain, int row0, float* kmean_out, float* red) {
    constexpr int RPI = NT / LPR;
    const int tid = TID, sub = tid % LPR, rr = tid / LPR;
    float g[8], am[8];
#pragma unroll
    for (int i = 0; i < 8; ++i) { g[i] = gain[sub * 8 + i]; am[i] = 0.f; }
    for (int it = 0; it < 256 / RPI; ++it) {
        bf16_t* rp = buf + (size_t)(row0 + it * RPI + rr) * ld + col0 + sub * 8;
        const u32x4 v = *(const u32x4*)rp;
        float x[8] = {bf_lo(v.x), bf_hi(v.x), bf_lo(v.y), bf_hi(v.y), bf_lo(v.z), bf_hi(v.z), bf_lo(v.w), bf_hi(v.w)};
        float ss = 0.f;
#pragma unroll
        for (int i = 0; i < 8; ++i) ss += x[i] * x[i];
#pragma unroll
        for (int o = 1; o < LPR; o <<= 1) ss += __shfl_xor(ss, o);
        const float rstd = rsqrtf(ss * (1.0f / (LPR * 8)) + EPS);
#pragma unroll
        for (int i = 0; i < 8; ++i) { x[i] = x[i] * rstd * g[i]; if (MEAN) am[i] += x[i]; }
        u32x4 o; o.x = pk_bf16(x[0], x[1]); o.y = pk_bf16(x[2], x[3]); o.z = pk_bf16(x[4], x[5]); o.w = pk_bf16(x[6], x[7]);
        *(u32x4*)rp = o;
    }
    if (MEAN) {
        __syncthreads();
#pragma unroll
        for (int i = 0; i < 8; ++i) red[rr * 64 + sub * 8 + i] = am[i];
        __syncthreads();
        if (tid < 64) {
            float s = 0.f;
            for (int r = 0; r < RPI; ++r) s += red[r * 64 + tid];
            kmean_out[tid] = s * (1.0f / 256.0f);
        }
    }
}

DEV void even_post(const Params& p, int li, char* smem) {
    char* ws = p.ws;
    bf16_t* EB = (bf16_t*)(ws + OFF_EB);
    float* red = (float*)smem;
    for (int it = BID; it < 2048 + 64; it += gridDim.x) {
        if (it < 2048) {
            const int blk = it >> 4, hh = it & 15;
            rownorm_block<8, false>(EB, 2048, hh * 64, (hh < 8 ? p.ev_qn : p.ev_kn) + li * 64, blk * 256, nullptr, red);
        } else {
            const int bh = it - 2048, b = bh >> 3, h = bh & 7, tid = TID, lane = tid & 63, wid = tid >> 6;
            const float* FA = (const float*)(ws + OFF_FA);
            float* CD = (float*)(ws + OFF_CDEC) + (size_t)bh * 4096;
            const float fb = p.ev_fb[li * 8 + h];
            float lf[8]; float run = 0.f;
#pragma unroll
            for (int i = 0; i < 8; ++i) {
                const float z = FA[(size_t)(b * 4096 + tid * 8 + i) * 8 + h] + fb;
                const float ls = fminf(z, 0.f) - log1pf(expf(-fabsf(z)));
                run += ls; lf[i] = run;
            }
            float inc = run;
#pragma unroll
            for (int o = 1; o < 64; o <<= 1) { const float y = __shfl_up(inc, o); if (lane >= o) inc += y; }
            __syncthreads();
            if (lane == 63) red[wid] = inc;
            __syncthreads();
            float base = inc - run;
            for (int w = 0; w < wid; ++w) base += red[w];
#pragma unroll
            for (int i = 0; i < 8; ++i) CD[tid * 8 + i] = (base + lf[i]) * LOG2E;
            __syncthreads();
        }
    }
}

DEV void odd_post1(const Params& p, int li, char* smem) {
    char* ws = p.ws;
    bf16_t* OB = (bf16_t*)(ws + OFF_EB);
    float* red = (float*)smem;
    float* KM = (float*)(ws + OFF_KMEAN);
    for (int it = BID; it < 2304; it += gridDim.x) {
        if (it < 1024) {
            const int blk = it >> 3, h = it & 7, b = blk >> 4, nb = blk & 15;
            rownorm_block<8, true>(OB, 1536, 512 + h * 64, p.od_mkn + li * 64, blk * 256, KM + (size_t)((b * 8 + h) * 16 + nb) * 64, red);
            __syncthreads();
        } else if (it < 2048) {
            const int j = it - 1024, blk = j >> 3, h = j & 7;
            rownorm_block<8, false>(OB, 1536, h * 64, p.od_mqn + li * 64, blk * 256, nullptr, red);
        } else if (it < 2176) {
            rownorm_block<32, false>(OB, 1536, 1024, p.od_qan + li * 256, (it - 2048) * 256, nullptr, red);
        } else {
            rownorm_block<16, false>(OB, 1536, 1280, p.od_kvan + li * 128, (it - 2176) * 256, nullptr, red);
        }
    }
}

DEV void moba_gate(const Params& p) {
    char* ws = p.ws;
    const bf16_t* OB = (const bf16_t*)(ws + OFF_EB);
    const float* KM = (const float*)(ws + OFF_KMEAN);
    int* SEL = (int*)(ws + OFF_SEL);
    const int gt = BID * blockDim.x + TID, gn = gridDim.x * blockDim.x;
    for (int w = gt; w < 8 * M_TOK; w += gn) {
        const int h = w >> 15, token = w & (M_TOK - 1), b = token >> 12, s = token & 4095, cur = s >> 8;
        float q[64];
        const u32x4* qp = (const u32x4*)(OB + (size_t)token * 1536 + h * 64);
#pragma unroll
        for (int i = 0; i < 8; ++i) { const u32x4 v = qp[i]; q[8 * i] = bf_lo(v.x); q[8 * i + 1] = bf_hi(v.x); q[8 * i + 2] = bf_lo(v.y); q[8 * i + 3] = bf_hi(v.y);
            q[8 * i + 4] = bf_lo(v.z); q[8 * i + 5] = bf_hi(v.z); q[8 * i + 6] = bf_lo(v.w); q[8 * i + 7] = bf_hi(v.w); }
        float v1 = -INFINITY, v2 = -INFINITY, v3 = -INFINITY; int i1 = -1, i2 = -1, i3 = -1;
        const float* kmb = KM + (size_t)((b * 8 + h) * 16) * 64;
        for (int n = 0; n < cur; ++n) {
            const f32x4* km = (const f32x4*)(kmb + n * 64);
            float d = 0.f;
#pragma unroll
            for (int i = 0; i < 16; ++i) { const f32x4 k4 = km[i]; d += q[4 * i] * k4[0] + q[4 * i + 1] * k4[1] + q[4 * i + 2] * k4[2] + q[4 * i + 3] * k4[3]; }
            if (d > v1) { v3 = v2; i3 = i2; v2 = v1; i2 = i1; v1 = d; i1 = n; }
            else if (d > v2) { v3 = v2; i3 = i2; v2 = d; i2 = n; }
            else if (d > v3) { v3 = d; i3 = n; }
        }
        int m = 0;
        if (i1 >= 0) m |= 1 << i1;
        if (i2 >= 0) m |= 1 << i2;
        if (i3 >= 0) m |= 1 << i3;
        SEL[(size_t)(b * 8 + h) * 4096 + s] = m;
    }
}

DEV void mla_post(const Params& p, int li) {
    char* ws = p.ws;
    bf16_t* QD = (bf16_t*)(ws + OFF_QD);
    bf16_t* KD = (bf16_t*)(ws + OFF_KD);
    const bf16_t* OB = (const bf16_t*)(ws + OFF_EB);
    const float* rope = (const float*)(ws + OFF_ROPE);
    const int gt = BID * blockDim.x + TID, gn = gridDim.x * blockDim.x;
    for (int w = gt; w < 2 * 8 * M_TOK; w += gn) {
        const int isk = w >> 18, rem = w & ((1 << 18) - 1), token = rem >> 3, h = rem & 7, s = token & 4095;
        bf16_t* rp = (isk ? KD : QD) + (size_t)token * 768 + h * 96;
        const float* gain = (isk ? p.od_lkn : p.od_lqn) + li * 96;
        float x[96];
#pragma unroll
        for (int i = 0; i < 12; ++i) {
            u32x4 v;
            if (isk && i >= 8) v = *(const u32x4*)(OB + (size_t)token * 1536 + 1408 + (i - 8) * 8);
            else v = *(const u32x4*)(rp + i * 8);
            x[8 * i] = bf_lo(v.x); x[8 * i + 1] = bf_hi(v.x); x[8 * i + 2] = bf_lo(v.y); x[8 * i + 3] = bf_hi(v.y);
            x[8 * i + 4] = bf_lo(v.z); x[8 * i + 5] = bf_hi(v.z); x[8 * i + 6] = bf_lo(v.w); x[8 * i + 7] = bf_hi(v.w);
        }
        float ss = 0.f;
#pragma unroll
        for (int i = 0; i < 96; ++i) ss += x[i] * x[i];
        const float rstd = rsqrtf(ss * (1.0f / 96.0f) + EPS);
#pragma unroll
        for (int i = 0; i < 96; ++i) x[i] = x[i] * rstd * gain[i];
        const float* cs = rope + (size_t)s * 16;
        const float* sn = rope + 4096 * 16 + (size_t)s * 16;
#pragma unroll
        for (int i = 0; i < 16; ++i) {
            const float c = cs[i], sv = sn[i], a = x[64 + i], bb = x[80 + i];
            x[64 + i] = a * c - bb * sv; x[80 + i] = a * sv + bb * c;
        }
#pragma unroll
        for (int i = 0; i < 12; ++i) {
            u32x4 o; o.x = pk_bf16(x[8 * i], x[8 * i + 1]); o.y = pk_bf16(x[8 * i + 2], x[8 * i + 3]); o.z = pk_bf16(x[8 * i + 4], x[8 * i + 5]); o.w = pk_bf16(x[8 * i + 6], x[8 * i + 7]);
            *(u32x4*)(rp + i * 8) = o;
        }
    }
}

enum { AT_FOX = 0, AT_SB, AT_MOBA, AT_MLA };
constexpr int AT_KBUF = 13312, AT_VBUF = 8192, AT_K0 = 0, AT_V0 = 2 * AT_KBUF, AT_MISC = AT_V0 + 2 * AT_VBUF, AT_CK = AT_MISC + 1024;

template <int MODE>
DEV void attn_item(const Params& p, char* smem, int b, int h, int qt) {
    constexpr int DQK = (MODE == AT_MLA) ? 96 : 64;
    constexpr int NKS = DQK / 32;
    constexpr int KSTRB = (DQK + 8) * 2;
    constexpr int KCH = DQK / 8;
    constexpr int KLD = (64 * KCH + NT - 1) / NT;
    char* ws = p.ws;
    const int tid = TID, wid = tid >> 6, lane = tid & 63, fr = lane & 15, fq = lane >> 4;
    const bf16_t* Qb; const bf16_t* Kb; int ldq; int head16;
    if (MODE == AT_FOX) { Qb = (const bf16_t*)(ws + OFF_EB) + h * 64; Kb = Qb + 512; ldq = 2048; head16 = h; }
    else if (MODE == AT_SB) { Qb = (const bf16_t*)(ws + OFF_EB) + 1024 + h * 64; Kb = Qb + 512; ldq = 2048; head16 = 8 + h; }
    else if (MODE == AT_MOBA) { Qb = (const bf16_t*)(ws + OFF_EB) + h * 64; Kb = Qb + 512; ldq = 1536; head16 = h; }
    else { Qb = (const bf16_t*)(ws + OFF_QD) + h * 96; Kb = (const bf16_t*)(ws + OFF_KD) + h * 96; ldq = 768; head16 = 8 + h; }
    const bf16_t* Vt = (const bf16_t*)(ws + OFF_VT) + (size_t)((b * 16 + head16) * 64) * 4096;
    const size_t tokb = (size_t)b * 4096;
    const int qw0 = qt * 128 + wid * 16;
    const int qpos = qw0 + fr;
    const int tlast = 2 * qt + 1;
    int* smi = (int*)(smem + AT_MISC);
    float* btab = (float*)(smem + AT_MISC + 512);

    __syncthreads();
    int mysel = 0;
    if (MODE == AT_MOBA) {
        mysel = ((const int*)(ws + OFF_SEL))[(size_t)(b * 8 + h) * 4096 + qpos];
        if (tid == 0) smi[73] = 0;
        if (tid < 128) btab[tid] = ((const float*)(ws + OFF_BTAB))[h * 128 + tid];
        __syncthreads();
        if (fq == 0) atomicOr(&smi[73], mysel);
        __syncthreads();
    }
    if (tid == 0) {
        int n = 0;
        if (MODE == AT_FOX || MODE == AT_MLA) { for (int t = 0; t <= tlast; ++t) smi[n++] = t; }
        else if (MODE == AT_SB) { for (int t = tlast; t >= 0; --t) smi[n++] = t; }
        else {
            const int cur = qt >> 1, um = smi[73];
            for (int t = cur * 4; t <= tlast; ++t) smi[n++] = t;
            for (int kb = 0; kb < cur; ++kb) if ((um >> kb) & 1) { for (int t = 0; t < 4; ++t) smi[n++] = kb * 4 + t; }
        }
        smi[72] = n;
    }
    __syncthreads();
    const int nt = smi[72];

    bf16x8 qf[NKS];
    {
        const bf16_t* qp = Qb + (tokb + qpos) * ldq + fq * 8;
#pragma unroll
        for (int ks = 0; ks < NKS; ++ks) qf[ks] = *(const bf16x8*)(qp + ks * 32);
    }
    float cq = 0.f;
    const float* CD = (const float*)(ws + OFF_CDEC) + (size_t)(b * 8 + h) * 4096;
    if (MODE == AT_FOX) cq = CD[qpos];
    const float c1 = (MODE == AT_MLA ? 0.10206207261596577f : 0.125f) * (MODE == AT_SB ? 1.0f : LOG2E);
    const float bfar = (MODE == AT_MOBA) ? btab[127] : 0.f;

    f32x4 o[4];
#pragma unroll
    for (int i = 0; i < 4; ++i) o[i] = (f32x4){0.f, 0.f, 0.f, 0.f};
    float mrun = -1e30f, lsum = 0.f, R = 0.f;

    u32x4 rk[KLD], rv; f32x4 rc = (f32x4){0.f, 0.f, 0.f, 0.f};
    auto gload = [&](int tile) {
        if (MODE == AT_FOX) { if (tid < 16) rc = *(const f32x4*)(CD + tile * 64 + tid * 4); }
#pragma unroll
        for (int i = 0; i < KLD; ++i) { const int idx = tid + NT * i, r = idx / KCH, c = idx % KCH; if (idx < 64 * KCH) rk[i] = *(const u32x4*)(Kb + (tokb + tile * 64 + r) * ldq + c * 8); }
        { const int d = tid >> 3, c8 = tid & 7; rv = *(const u32x4*)(Vt + (size_t)d * 4096 + tile * 64 + c8 * 8); }
    };
    auto lstore = [&](int buf) {
        char* kb = smem + AT_K0 + buf * AT_KBUF; char* vb = smem + AT_V0 + buf * AT_VBUF;
        if (MODE == AT_FOX) { if (tid < 16) *(f32x4*)(smem + AT_CK + buf * 256 + tid * 16) = rc; }
#pragma unroll
        for (int i = 0; i < KLD; ++i) { const int idx = tid + NT * i, r = idx / KCH, c = idx % KCH; if (idx < 64 * KCH) *(u32x4*)(kb + r * KSTRB + c * 16) = rk[i]; }
        { const int d = tid >> 3, c8 = tid & 7; *(u32x4*)(vb + ((c8 >> 1) * 64 + d) * 32 + (c8 & 1) * 16) = rv; }
    };
    gload(smi[0]); lstore(0);
    __syncthreads();
    for (int it = 0; it < nt; ++it) {
        const int tile = smi[it], buf = it & 1;
        const bool more = it + 1 < nt;
        if (more) gload(smi[it + 1]);
        const char* kb = smem + AT_K0 + buf * AT_KBUF; const char* vb = smem + AT_V0 + buf * AT_VBUF;
        const int kbase = tile * 64 + fq * 4;
        const bool wave_live = (MODE == AT_SB) ? (tile * 64 < qw0 + 15) : (tile * 64 <= qw0 + 15);
        const bool diag = (tile * 64 + 63 >= qw0);
        if (wave_live) {
        f32x4 s[4];
#pragma unroll
        for (int kt = 0; kt < 4; ++kt) {
            s[kt] = (f32x4){0.f, 0.f, 0.f, 0.f};
#pragma unroll
            for (int ks = 0; ks < NKS; ++ks) {
                const bf16x8 kf = *(const bf16x8*)(kb + (kt * 16 + fr) * KSTRB + (ks * 32 + fq * 8) * 2);
                s[kt] = __builtin_amdgcn_mfma_f32_16x16x32_bf16(kf, qf[ks], s[kt], 0, 0, 0);
            }
        }
        const bool far_tile = (MODE == AT_MOBA) && (qt * 128 - (tile * 64 + 63) >= 127);
        unsigned pp[4][2];
        if (MODE == AT_SB) {
            float T[4], exq[4], ls[4][4], e[4][4];
#pragma unroll
            for (int kt = 0; kt < 4; ++kt) {
                float v[4];
#pragma unroll
                for (int j = 0; j < 4; ++j) {
                    const float z = s[kt][j] * c1;
                    const float sp = __logf(1.0f + __expf(-fabsf(z)));
                    const float l = fminf(z, 0.f) - sp;
                    const bool strict = !diag || (kbase + kt * 16 + j < qpos);
                    ls[kt][j] = strict ? l : -INFINITY;
                    v[j] = strict ? (l - z) : 0.f;
                }
                e[kt][3] = 0.f; e[kt][2] = v[3]; e[kt][1] = v[3] + v[2]; e[kt][0] = e[kt][1] + v[1];
                const float G = e[kt][0] + v[0];
                float xs = G;
                float y = __shfl_down(xs, 16); if (fq < 3) xs += y;
                y = __shfl_down(xs, 32); if (fq < 2) xs += y;
                exq[kt] = xs - G;
                T[kt] = __shfl(xs, fr);
            }
            float off = R;
#pragma unroll
            for (int kt = 3; kt >= 0; --kt) {
                float w[4];
#pragma unroll
                for (int j = 0; j < 4; ++j) w[j] = __expf(ls[kt][j] + off + exq[kt] + e[kt][j]);
                pp[kt][0] = pk_bf16(w[0], w[1]); pp[kt][1] = pk_bf16(w[2], w[3]);
                off += T[kt];
            }
            R = off;
        } else {
            float t[4][4];
            float mx = -1e30f;
#pragma unroll
            for (int kt = 0; kt < 4; ++kt) {
                f32x4 bias = (f32x4){0.f, 0.f, 0.f, 0.f};
                if (MODE == AT_FOX) { const f32x4 ck = *(const f32x4*)(smem + AT_CK + buf * 256 + (kt * 16 + fq * 4) * 4); bias = (f32x4){cq, cq, cq, cq} - ck; }
                bool blk_ok = true;
                if (MODE == AT_MOBA) {
                    blk_ok = (tile >> 2) == (qt >> 1) || ((mysel >> (tile >> 2)) & 1);
                    if (far_tile) { bias = (f32x4){bfar, bfar, bfar, bfar}; }
                    else {
#pragma unroll
                        for (int j = 0; j < 4; ++j) { int dist = qpos - (kbase + kt * 16 + j); dist = dist < 0 ? 0 : (dist > 127 ? 127 : dist); bias[j] = btab[dist]; }
                    }
                }
#pragma unroll
                for (int j = 0; j < 4; ++j) {
                    float v = s[kt][j] * c1 + bias[j];
                    const bool ok = blk_ok && (!diag || (kbase + kt * 16 + j <= qpos));
                    v = ok ? v : -1e30f;
                    t[kt][j] = v; mx = fmaxf(mx, v);
                }
            }
            mx = fmaxf(mx, __shfl_xor(mx, 16)); mx = fmaxf(mx, __shfl_xor(mx, 32));
            const float mnew = fmaxf(mrun, mx);
            const float alpha = __builtin_amdgcn_exp2f(mrun - mnew);
            mrun = mnew;
            float ps = 0.f;
#pragma unroll
            for (int kt = 0; kt < 4; ++kt) {
                float w[4];
#pragma unroll
                for (int j = 0; j < 4; ++j) { w[j] = __builtin_amdgcn_exp2f(t[kt][j] - mnew); ps += w[j]; }
                pp[kt][0] = pk_bf16(w[0], w[1]); pp[kt][1] = pk_bf16(w[2], w[3]);
            }
            lsum = lsum * alpha + ps;
#pragma unroll
            for (int i = 0; i < 4; ++i) o[i] = o[i] * alpha;
        }
#pragma unroll
        for (int kk = 0; kk < 2; ++kk) {
            u32x4 pw; pw.x = pp[2 * kk][0]; pw.y = pp[2 * kk][1]; pw.z = pp[2 * kk + 1][0]; pw.w = pp[2 * kk + 1][1];
            const bf16x8 pf = __builtin_bit_cast(bf16x8, pw);
#pragma unroll
            for (int dt = 0; dt < 4; ++dt) {
                const u32x2 lo = *(const u32x2*)(vb + ((2 * kk) * 64 + dt * 16 + fr) * 32 + fq * 8);
                const u32x2 hi = *(const u32x2*)(vb + ((2 * kk + 1) * 64 + dt * 16 + fr) * 32 + fq * 8);
                u32x4 vw; vw.x = lo.x; vw.y = lo.y; vw.z = hi.x; vw.w = hi.y;
                o[dt] = __builtin_amdgcn_mfma_f32_16x16x32_bf16(__builtin_bit_cast(bf16x8, vw), pf, o[dt], 0, 0, 0);
            }
        }
        }
        if (more) lstore(buf ^ 1);
        if (MODE == AT_SB) {
            if (__syncthreads_and(R < -40.0f)) break;
        } else {
            __syncthreads();
        }
    }
    float inv = 1.0f;
    if (MODE != AT_SB) {
        float l = lsum; l += __shfl_xor(l, 16); l += __shfl_xor(l, 32);
        inv = 1.0f / l;
    }
    bf16_t* op = (bf16_t*)(ws + OFF_HM) + (tokb + qpos) * 1024 + head16 * 64 + fq * 4;
#pragma unroll
    for (int dt = 0; dt < 4; ++dt) {
        u32x2 w; w.x = pk_bf16(o[dt][0] * inv, o[dt][1] * inv); w.y = pk_bf16(o[dt][2] * inv, o[dt][3] * inv);
        *(u32x2*)(op + dt * 16) = w;
    }
}

DEV void attn_phase(const Params& p, char* smem, bool even, unsigned* ctr) {
    int* smi = (int*)(smem + AT_MISC);
    const int tid = TID;
    for (;;) {
        __syncthreads();
        if (tid == 0) smi[74] = (int)__hip_atomic_fetch_add(ctr, 1u, __ATOMIC_RELAXED, __HIP_MEMORY_SCOPE_AGENT);
        __syncthreads();
        const int it = smi[74];
        if (it >= 32 * 128) break;
        const int qt = 31 - (it >> 7), bh = it & 127, b = bh >> 4, h16 = bh & 15;
        if (even) { if (h16 < 8) attn_item<AT_FOX>(p, smem, b, h16, qt); else attn_item<AT_SB>(p, smem, b, h16 - 8, qt); }
        else { if (h16 < 8) attn_item<AT_MOBA>(p, smem, b, h16, qt); else attn_item<AT_MLA>(p, smem, b, h16 - 8, qt); }
    }
}

DEV void gsync(unsigned* ctr, unsigned& target) {
    asm volatile("s_waitcnt vmcnt(0) lgkmcnt(0)" ::: "memory");
    __syncthreads();
    target += gridDim.x;
    if (threadIdx.x == 0) {
        __builtin_amdgcn_fence(__ATOMIC_RELEASE, "agent");
        __hip_atomic_fetch_add(ctr, 1u, __ATOMIC_RELAXED, __HIP_MEMORY_SCOPE_AGENT);
        while (__hip_atomic_load(ctr, __ATOMIC_RELAXED, __HIP_MEMORY_SCOPE_AGENT) < target) __builtin_amdgcn_s_sleep(1);
        __builtin_amdgcn_fence(__ATOMIC_ACQUIRE, "agent");
    }
    __syncthreads();
}

enum { OP_NORM_MIX = 0, OP_GEMM_IN, OP_EPOST, OP_OPOST1, OP_GEMM_QB, OP_GEMM_KVB, OP_GATE, OP_MLAPOST, OP_ATTN, OP_GEMM_OUT, OP_NORM_FFN, OP_GEMM_GU, OP_GEMM_DN };

__global__ void __launch_bounds__(512) fwd_megakernel(Params p) {
    extern __shared__ __attribute__((aligned(16))) char smem[];
    cg::grid_group grid = cg::this_grid();
    char* ws = p.ws;
    unsigned* bar = (unsigned*)(ws + OFF_BAR);
    unsigned btarget = 0;
    grid.sync();
    for (int rep = 0; rep < DBG_REP_SMALL; ++rep) prologue(p, smem);
    gsync(bar, btarget);
    for (int gs = 0; gs < 40; ++gs) {
        {
            const int gq = opq_s(gs);
#ifdef DBG_STEPS
            if (gq >= DBG_STEPS) break;
#endif
            const int pair = gq / 20, rr20 = gq - pair * 20;
            const bool even = rr20 < 8;
            const int step = even ? rr20 : rr20 - 8;
            const int layer = pair * 2 + (even ? 0 : 1), li = pair;
            const float* xin = layer == 0 ? p.x : p.out;
            int op; bool sync = true;
            if (even) {
                switch (step) { case 0: op = OP_NORM_MIX; break; case 1: op = OP_GEMM_IN; break; case 2: op = OP_EPOST; break; case 3: op = OP_ATTN; break;
                                case 4: op = OP_GEMM_OUT; break; case 5: op = OP_NORM_FFN; break; case 6: op = OP_GEMM_GU; break; default: op = OP_GEMM_DN; break; }
            } else {
                switch (step) { case 0: op = OP_NORM_MIX; break; case 1: op = OP_GEMM_IN; break; case 2: op = OP_OPOST1; break; case 3: op = OP_GEMM_QB; break;
                                case 4: op = OP_GEMM_KVB; break; case 5: op = OP_GATE; break; case 6: op = OP_MLAPOST; break; case 7: op = OP_ATTN; break;
                                case 8: op = OP_GEMM_OUT; break; case 9: op = OP_NORM_FFN; break; case 10: op = OP_GEMM_GU; break; default: op = OP_GEMM_DN; break; }
            }
            if (op == OP_GEMM_QB || op == OP_GEMM_KVB) sync = false;
            bool jp = false, jv = false, jr = false, jg = false;
            const bf16_t *pA = nullptr, *pB = nullptr, *vA = nullptr, *vB = nullptr, *rA = nullptr, *rB = nullptr;
            int pldA = 0, pN = 0, pK = 0, vM = 0, vldB = 0, vK = 0, rK = 0, vhead = 0;
            EpiPlain eP{nullptr, 0, 0}; const float* rxin = nullptr;
            switch (op) {
            case OP_NORM_MIX: for (int rep = 0; rep < DBG_REP_SMALL; ++rep) norm_phase(xin, (even ? p.ev_norm : p.od_norm) + li * DM, (bf16_t*)(ws + OFF_HM), even ? p.ev_w_in + (size_t)li * 1024 * 3080 : nullptr, (float*)(ws + OFF_FA), smem); break;
            case OP_NORM_FFN: for (int rep = 0; rep < DBG_REP_SMALL; ++rep) norm_phase(p.out, p.ffn_norm + layer * DM, (bf16_t*)(ws + OFF_HM), nullptr, nullptr, smem); break;
            case OP_EPOST: even_post(p, li, smem); break;
            case OP_OPOST1: odd_post1(p, li, smem); break;
            case OP_GATE: for (int rep = 0; rep < DBG_REP_SMALL; ++rep) moba_gate(p); break;
            case OP_MLAPOST: mla_post(p, li); break;
            case OP_ATTN: attn_phase(p, smem, even, bar + 16 + layer); break;
            case OP_GEMM_IN:
                jp = jv = true; pA = (const bf16_t*)(ws + OFF_HM); pldA = 1024; pK = 1024; vB = pA; vldB = 1024; vK = 1024; vhead = 0;
                if (even) { pB = (const bf16_t*)(ws + OFF_EVIN) + li * SZ_EVIN; pN = 2048; eP = EpiPlain{(bf16_t*)(ws + OFF_EB), 2048, 0}; vA = pB + (size_t)2048 * 1024; vM = 1024; }
                else { pB = (const bf16_t*)(ws + OFF_ODIN) + li * SZ_ODIN; pN = 1536; eP = EpiPlain{(bf16_t*)(ws + OFF_EB), 1536, 0}; vA = pB + (size_t)1536 * 1024; vM = 512; }
                break;
            case OP_GEMM_QB:
                jp = true; pA = (const bf16_t*)(ws + OFF_EB) + 1024; pldA = 1536; pK = 256; pB = (const bf16_t*)(ws + OFF_QB) + li * SZ_QB; pN = 768; eP = EpiPlain{(bf16_t*)(ws + OFF_QD), 768, 0};
                break;
            case OP_GEMM_KVB:
                jp = jv = true; pA = (const bf16_t*)(ws + OFF_EB) + 1280; pldA = 1536; pK = 128; pB = (const bf16_t*)(ws + OFF_KVB) + li * SZ_KVB; pN = 512; eP = EpiPlain{(bf16_t*)(ws + OFF_KD), 768, 1};
                vA = pB + (size_t)512 * 128; vM = 512; vB = pA; vldB = 1536; vK = 128; vhead = 8;
                break;
            case OP_GEMM_OUT:
                jr = true; rA = (const bf16_t*)(ws + OFF_HM); rK = 1024; rB = (const bf16_t*)(ws + (even ? OFF_EVOUT : OFF_ODOUT)) + li * SZ_OUT; rxin = xin;
                break;
            case OP_GEMM_GU: jg = true; break;
            default:
                jr = true; rA = (const bf16_t*)(ws + OFF_ACT); rK = DFF; rB = (const bf16_t*)(ws + OFF_DN) + layer * SZ_DN; rxin = p.out;
                break;
            }
            if (jp) run_gemm(smem, pA, pldA, M_TOK, pB, pK, pN, pK, eP);
            if (jv) run_gemm(smem, vA, vK, vM, vB, vldB, M_TOK, vK, EpiVT{(bf16_t*)(ws + OFF_VT), vhead});
            if (jr) run_gemm(smem, rA, rK, M_TOK, rB, rK, 1024, rK, EpiResid{rxin, p.out});
            for (int rep = 0; rep < DBG_REP_GU; ++rep)
            if (jg) run_gemm(smem, (const bf16_t*)(ws + OFF_HM), 1024, M_TOK, (const bf16_t*)(ws + OFF_GU) + layer * SZ_GU, 1024, 5632, 1024, EpiSwiglu{(bf16_t*)(ws + OFF_ACT)});
            if (sync) gsync(bar, btarget);
            if (DBG_EXTRA_SYNC) gsync(bar, btarget);
        }
    }
#ifdef DBG_STEPS
    gsync(bar, btarget);
    {
        const size_t n = (size_t)M_TOK * 1024;
        const bf16_t* b0 = (const bf16_t*)(ws + OFF_HM);
        const bf16_t* b1 = (const bf16_t*)(ws + DBG_OFF1);
        const bf16_t* b2 = (const bf16_t*)(ws + DBG_OFF2);
        const bf16_t* b3 = (const bf16_t*)(ws + OFF_EB + (size_t)M_TOK * 1024 * 2);
        for (size_t i = (size_t)blockIdx.x * NT + threadIdx.x; i < n; i += (size_t)gridDim.x * NT) {
            float v = bf_lo(b0[i]) + bf_lo(b1[i]) + bf_lo(b2[i]) + bf_lo(b3[i]);
            if (DBG_STEPS >= 5) v += p.out[i];
            p.out[i] = v;
        }
    }
#endif
}

extern "C" void kernel_launch(void* const* d_in, const int* in_sizes, int n_in, void* d_out, int out_size, void* d_ws, size_t ws_size,
                              hipStream_t stream) {
    if (ws_size < OFF_END + 256) return;
    static int grid_blocks = 0;
    if (!grid_blocks) {
        int dev = 0, cus = 0, per_cu = 0;
        hipGetDevice(&dev);
        hipDeviceGetAttribute(&cus, hipDeviceAttributeMultiprocessorCount, dev);
        hipFuncSetAttribute((const void*)fwd_megakernel, hipFuncAttributeMaxDynamicSharedMemorySize, SMEM_BYTES);
        hipOccupancyMaxActiveBlocksPerMultiprocessor(&per_cu, fwd_megakernel, NT, SMEM_BYTES);
        if (per_cu > 1) per_cu = 1;
        if (per_cu < 1) per_cu = 1;
        grid_blocks = cus * per_cu;
    }
    Params p{};
    p.x = (const float*)d_in[0]; p.ffn_norm = (const float*)d_in[1]; p.w_gu = (const float*)d_in[2]; p.w_dn = (const float*)d_in[3];
    p.rel_bias = (const float*)d_in[4]; p.ev_norm = (const float*)d_in[5]; p.ev_w_in = (const float*)d_in[6]; p.ev_fb = (const float*)d_in[7];
    p.ev_qn = (const float*)d_in[8]; p.ev_kn = (const float*)d_in[9]; p.ev_w_out = (const float*)d_in[10]; p.od_norm = (const float*)d_in[11];
    p.od_w_in = (const float*)d_in[12]; p.od_mqn = (const float*)d_in[13]; p.od_mkn = (const float*)d_in[14]; p.od_qan = (const float*)d_in[15];
    p.od_wqb = (const float*)d_in[16]; p.od_kvan = (const float*)d_in[17]; p.od_wkvb = (const float*)d_in[18]; p.od_lqn = (const float*)d_in[19];
    p.od_lkn = (const float*)d_in[20]; p.od_w_out = (const float*)d_in[21];
    p.out = (float*)d_out; p.ws = (char*)d_ws;
    hipMemsetAsync((char*)d_ws + OFF_BAR, 0, 256, stream);
    void* args[] = {&p};
    hipError_t e = hipLaunchCooperativeKernel((void*)fwd_megakernel, dim3(grid_blocks), dim3(NT), args, SMEM_BYTES, stream);
    if (e != hipSuccess) fprintf(stderr, "cooperative launch failed: %s (grid %d)\n", hipGetErrorString(e), grid_blocks);
}
```

```cpp
#include <hip/hip_runtime.h>
#include <hip/hip_cooperative_groups.h>
#include <cstdio>
#include <cstdint>
#include <type_traits>
namespace cg = cooperative_groups;

typedef unsigned short bf16_t;
typedef short bf16x8 __attribute__((ext_vector_type(8)));
typedef float f32x4 __attribute__((ext_vector_type(4)));
typedef unsigned u32x4 __attribute__((ext_vector_type(4)));
typedef unsigned u32x2 __attribute__((ext_vector_type(2)));

#define DEV __device__ __forceinline__
#define NO_SB_EXIT 0
#define DBG_REP_ATTN 1
#define DBG_REP_GU 1
#define DBG_REP_SMALL 1
#define DBG_EXTRA_SYNC 0
#define DBG_SKIP_SB 0
#define DBG_NOSHFL 0
#define DBG_SKIP_FOX 0
#define DBG_OFF1 OFF_EB
#define DBG_OFF2 OFF_VT

constexpr int M_TOK = 32768, SEQ = 4096, DM = 1024, DFF = 2816;
constexpr float EPS = 1e-6f;
constexpr float LOG2E = 1.4426950408889634f;

constexpr size_t SZ_EVIN = 3200ull * 1024, SZ_ODIN = 2048ull * 1024, SZ_OUT = 1024ull * 1024, SZ_GU = 5632ull * 1024,
                 SZ_DN = 1024ull * 2816, SZ_QB = 768ull * 256, SZ_KVB = 1024ull * 128;
constexpr size_t OFF_EVIN = 0;
constexpr size_t OFF_ODIN = OFF_EVIN + 2 * SZ_EVIN * 2;
constexpr size_t OFF_EVOUT = OFF_ODIN + 2 * SZ_ODIN * 2;
constexpr size_t OFF_ODOUT = OFF_EVOUT + 2 * SZ_OUT * 2;
constexpr size_t OFF_GU = OFF_ODOUT + 2 * SZ_OUT * 2;
constexpr size_t OFF_DN = OFF_GU + 4 * SZ_GU * 2;
constexpr size_t OFF_QB = OFF_DN + 4 * SZ_DN * 2;
constexpr size_t OFF_KVB = OFF_QB + 2 * SZ_QB * 2;
constexpr size_t OFF_HM = OFF_KVB + 2 * SZ_KVB * 2;
constexpr size_t OFF_EB = OFF_HM + (size_t)M_TOK * 1024 * 2;
constexpr size_t OFF_VT = OFF_EB + (size_t)M_TOK * 2048 * 2;
constexpr size_t OFF_QD = OFF_VT + (size_t)M_TOK * 1024 * 2;
constexpr size_t OFF_KD = OFF_QD + (size_t)M_TOK * 768 * 2;
constexpr size_t OFF_FA = OFF_KD + (size_t)M_TOK * 768 * 2;
constexpr size_t OFF_CDEC = OFF_FA + (size_t)M_TOK * 8 * 4;
constexpr size_t OFF_KMEAN = OFF_CDEC + 64ull * 4096 * 4;
constexpr size_t OFF_SEL = OFF_KMEAN + 8ull * 8 * 16 * 64 * 4;
constexpr size_t OFF_BTAB = OFF_SEL + 64ull * 4096 * 4;
constexpr size_t OFF_ROPE = OFF_BTAB + 8ull * 128 * 4;
constexpr size_t OFF_END = OFF_ROPE + 2ull * 4096 * 16 * 4;
constexpr size_t OFF_BAR = OFF_END;
constexpr size_t OFF_ACT = OFF_EB;
static_assert((size_t)M_TOK * DFF * 2 <= (size_t)M_TOK * 3072 * 2, "ACT overlay");

constexpr int SMEM_BYTES = 131072;
constexpr int NT = 512;

struct Params {
    const float* x; const float* ffn_norm; const float* w_gu; const float* w_dn; const float* rel_bias;
    const float* ev_norm; const float* ev_w_in; const float* ev_fb; const float* ev_qn; const float* ev_kn; const float* ev_w_out;
    const float* od_norm; const float* od_w_in; const float* od_mqn; const float* od_mkn; const float* od_qan; const float* od_wqb;
    const float* od_kvan; const float* od_wkvb; const float* od_lqn; const float* od_lkn; const float* od_w_out;
    float* out; char* ws;
};

typedef __bf16 bf16v2_t __attribute__((ext_vector_type(2)));
typedef float f32x2_t __attribute__((ext_vector_type(2)));
DEV unsigned pk_bf16(float lo, float hi) { f32x2_t v = {lo, hi}; bf16v2_t b = __builtin_convertvector(v, bf16v2_t); return __builtin_bit_cast(unsigned, b); }
DEV int opq_v(int x) { asm volatile("" : "+v"(x)); return x; }
DEV int opq_s(int x) { asm volatile("" : "+s"(x)); return x; }
#define TID opq_v((int)threadIdx.x)
#define BID opq_s((int)blockIdx.x)
DEV float bf_lo(unsigned u) { return __uint_as_float(u << 16); }
DEV float bf_hi(unsigned u) { return __uint_as_float(u & 0xffff0000u); }

enum { WM_ID = 0, WM_EVIN, WM_ODIN, WM_GU, WM_KVB };
DEV int srcmap(int mode, int n) {
    switch (mode) {
    case WM_EVIN:
        if (n < 1024) return n;
        if (n < 1536) return 1544 + (n - 1024);
        if (n < 2048) return 2056 + (n - 1536);
        if (n < 2560) return 1024 + (n - 2048);
        if (n < 3072) return 2568 + (n - 2560);
        return -1;
    case WM_ODIN:
        if (n < 1024) return n;
        if (n < 1280) return 1536 + (n - 1024);
        if (n < 1408) return 1792 + (n - 1280);
        if (n < 1440) return 1920 + (n - 1408);
        if (n < 1536) return -1;
        return 1024 + (n - 1536);
    case WM_GU: { const int pn = n >> 8, bj = (n >> 7) & 1, t = n & 127; return bj * 2816 + 128 * pn + t; }
    case WM_KVB: { if (n < 512) return (n >> 6) * 128 + (n & 63); int m = n - 512; return (m >> 6) * 128 + 64 + (m & 63); }
    default: return n;
    }
}

DEV void convert_matrix(const float* __restrict__ W, bf16_t* __restrict__ Bt, int K, int N, int Np, int mode, float* lds) {
    const int tid = TID;
    const int nkt = K >> 6, ntiles = (Np >> 6) * nkt;
    for (int t = BID; t < ntiles; t += gridDim.x) {
        const int k0 = (t % nkt) << 6, n0 = (t / nkt) << 6;
        const int nn = tid & 63, src = srcmap(mode, n0 + nn);
        __syncthreads();
#pragma unroll 4
        for (int i = 0; i < 8; ++i) {
            const int kk = (tid >> 6) + 8 * i;
            lds[nn * 65 + kk] = src >= 0 ? W[(size_t)(k0 + kk) * N + src] : 0.f;
        }
        __syncthreads();
        const int r = tid >> 3, c = tid & 7;
        const float* lp = lds + r * 65 + c * 8;
        u32x4 a;
        a.x = pk_bf16(lp[0], lp[1]); a.y = pk_bf16(lp[2], lp[3]); a.z = pk_bf16(lp[4], lp[5]); a.w = pk_bf16(lp[6], lp[7]);
        *(u32x4*)(Bt + (size_t)(n0 + r) * K + k0 + c * 8) = a;
    }
}

DEV void prologue(const Params& p, char* smem) {
    float* lds = (float*)smem;
    char* ws = p.ws;
    for (int i = 0; i < 2; ++i) {
        convert_matrix(p.ev_w_in + (size_t)i * 1024 * 3080, (bf16_t*)(ws + OFF_EVIN) + i * SZ_EVIN, 1024, 3080, 3072, WM_EVIN, lds);
        convert_matrix(p.od_w_in + (size_t)i * 1024 * 1952, (bf16_t*)(ws + OFF_ODIN) + i * SZ_ODIN, 1024, 1952, 2048, WM_ODIN, lds);
        convert_matrix(p.ev_w_out + (size_t)i * 1024 * 1024, (bf16_t*)(ws + OFF_EVOUT) + i * SZ_OUT, 1024, 1024, 1024, WM_ID, lds);
        convert_matrix(p.od_w_out + (size_t)i * 1024 * 1024, (bf16_t*)(ws + OFF_ODOUT) + i * SZ_OUT, 1024, 1024, 1024, WM_ID, lds);
        convert_matrix(p.od_wqb + (size_t)i * 256 * 768, (bf16_t*)(ws + OFF_QB) + i * SZ_QB, 256, 768, 768, WM_ID, lds);
        convert_matrix(p.od_wkvb + (size_t)i * 128 * 1024, (bf16_t*)(ws + OFF_KVB) + i * SZ_KVB, 128, 1024, 1024, WM_KVB, lds);
    }
    for (int l = 0; l < 4; ++l) {
        convert_matrix(p.w_gu + (size_t)l * 1024 * 5632, (bf16_t*)(ws + OFF_GU) + l * SZ_GU, 1024, 5632, 5632, WM_GU, lds);
        convert_matrix(p.w_dn + (size_t)l * 2816 * 1024, (bf16_t*)(ws + OFF_DN) + l * SZ_DN, 2816, 1024, 1024, WM_ID, lds);
    }
    const int gt = BID * blockDim.x + TID, gn = gridDim.x * blockDim.x;
    float* btab = (float*)(ws + OFF_BTAB);
    for (int i = gt; i < 8 * 128; i += gn) {
        const int h = i >> 7, n = i & 127;
        int bucket;
        if (n < 16) bucket = n;
        else { const float v = logf((float)n / 16.0f) / 2.0794415416798357f * 16.0f; bucket = 16 + (int)v; if (bucket > 31) bucket = 31; }
        btab[i] = p.rel_bias[h * 32 + bucket] * LOG2E;
    }
    float* rope = (float*)(ws + OFF_ROPE);
    for (int i = gt; i < 4096 * 16; i += gn) {
        const int pos = i >> 4, f = i & 15;
        const float inv = powf(10000.0f, -(float)f / 16.0f);
        const float ang = (float)pos * inv;
        const double a = (double)ang;
        const double r = a - 6.283185307179586476925 * rint(a * 0.15915494309189533577);
        const float fr_ = (float)(r * 0.15915494309189533577);
        rope[i] = __builtin_amdgcn_cosf(fr_);
        rope[4096 * 16 + i] = __builtin_amdgcn_sinf(fr_);
    }
}

DEV void norm_phase(const float* __restrict__ x, const float* __restrict__ gain, bf16_t* __restrict__ h, const float* __restrict__ wfa, float* __restrict__ FA, char* smem) {
    const int tid = TID, lane = tid & 63, wv = (BID * NT + tid) >> 6, nw = (gridDim.x * NT) >> 6;
    float* wl = (float*)smem;
    if (wfa) {
        __syncthreads();
        for (int i = tid; i < 8192; i += NT) { const int k = i >> 3, j = i & 7; wl[j * 1024 + k] = wfa[(size_t)k * 3080 + 1536 + j]; }
        __syncthreads();
    }
    f32x4 g[4];
#pragma unroll
    for (int i = 0; i < 4; ++i) g[i] = *(const f32x4*)(gain + 4 * (lane + 64 * i));
    for (int row = wv; row < M_TOK; row += nw) {
        const float* xr = x + (size_t)row * DM;
        f32x4 v[4]; float ss = 0.f;
#pragma unroll
        for (int i = 0; i < 4; ++i) { v[i] = *(const f32x4*)(xr + 4 * (lane + 64 * i)); ss += v[i][0] * v[i][0] + v[i][1] * v[i][1] + v[i][2] * v[i][2] + v[i][3] * v[i][3]; }
#pragma unroll
        for (int o = 32; o > 0; o >>= 1) ss += __shfl_xor(ss, o);
        const float rstd = rsqrtf(ss * (1.0f / DM) + EPS);
        bf16_t* hr = h + (size_t)row * DM;
#pragma unroll
        for (int i = 0; i < 4; ++i) {
            v[i] = v[i] * rstd * g[i];
            u32x2 o; o.x = pk_bf16(v[i][0], v[i][1]); o.y = pk_bf16(v[i][2], v[i][3]);
            *(u32x2*)(hr + 4 * (lane + 64 * i)) = o;
        }
        if (wfa) {
            float fs[8];
#pragma unroll
            for (int j = 0; j < 8; ++j) {
                float a = 0.f;
#pragma unroll
                for (int i = 0; i < 4; ++i) { const f32x4 w = *(const f32x4*)(wl + j * 1024 + 4 * (lane + 64 * i)); a += v[i][0] * w[0] + v[i][1] * w[1] + v[i][2] * w[2] + v[i][3] * w[3]; }
#pragma unroll
                for (int o = 32; o > 0; o >>= 1) a += __shfl_xor(a, o);
                fs[j] = a;
            }
            if (lane == 0) { *(f32x4*)(FA + (size_t)row * 8) = (f32x4){fs[0], fs[1], fs[2], fs[3]}; *(f32x4*)(FA + (size_t)row * 8 + 4) = (f32x4){fs[4], fs[5], fs[6], fs[7]}; }
        }
    }
}

namespace pg8 {
#define PG8_LAS __attribute__((address_space(3)))
constexpr int BM = 256, BK = 64, HALF = 128, HTB = HALF * BK * 2, STAGE_BYTES = 8 * HTB, NXCD = 8, WGM = 8;
DEV int lds_byte(int r, int c) { const int st = (r >> 4) * 2 + (c >> 5), rr = r & 15, cc = c & 31, ob = rr * 64 + cc * 2; return st * 1024 + (ob ^ (((ob >> 9) & 1) << 5)); }
DEV void stage_rc(int b, int& R, int& C) { const int st = b / 1024, sb = b % 1024, swz = sb ^ (((sb >> 9) & 1) << 5); R = (st >> 1) * 16 + swz / 64; C = (st & 1) * 32 + (swz % 64) / 2; }
DEV int perm32(int rho) { const int n = rho >> 4, i = rho & 15; return 8 * (i >> 2) + 4 * n + (i & 3); }
struct Unit { int pm, pn; };
struct Gemm { const bf16_t* A; const bf16_t* Bt; int M, N, K, ldA, ldB; };
struct StaticOrder {
    int nM, nN, nwg, G, c;
    DEV void init(int M, int N, int G_, int c_) { nM = M / BM; nN = N / BM; nwg = nM * nN; G = G_; c = c_; }
    DEV bool next(int i, Unit& u) const {
        const long L = (long)i * G + c; if (L >= nwg) return false;
        int wgid = (int)L; { const int q = nwg / NXCD, r = nwg % NXCD, xcd = wgid % NXCD, off = wgid / NXCD; wgid = (xcd < r ? xcd * (q + 1) : r * (q + 1) + (xcd - r) * q) + off; }
        const int nig = WGM * nN, gid = wgid / nig, fm = gid * WGM, gsz = (nM - fm) < WGM ? (nM - fm) : WGM;
        u.pm = fm + ((wgid % nig) % gsz); u.pn = (wgid % nig) / gsz; return true;
    }
};
template <class Epi>
DEV void gemm_phase(PG8_LAS unsigned char* lds, const Gemm g, const StaticOrder& S, const Epi& E) {
    const int tid = TID, wid = __builtin_amdgcn_readfirstlane(tid >> 6), lane = tid & 63, wr = wid >> 2, wc = wid & 3, fr = lane & 15, fq = lane >> 4;
    const int K = g.K, nt = K / BK;
    unsigned voffA[2], voffB[2];
#pragma unroll
    for (int i = 0; i < 2; ++i) { int R, C; stage_rc(tid * 16 + i * 8192, R, C); const int Rb = (R & ~31) + perm32(R & 31);
        voffA[i] = (unsigned)(R * g.ldA + C) * 2u; voffB[i] = (unsigned)(Rb * g.ldB + C) * 2u; }
    const size_t kstep = (size_t)(BK * 2);
    const size_t hstepA = (size_t)HALF * g.ldA * 2, hstepB = (size_t)HALF * g.ldB * 2, tstepA = 2 * hstepA, tstepB = 2 * hstepB;
    const unsigned ldsw = (unsigned)wid * 1024u;
    const int aoff = lds_byte(wr * 64 + fr, fq * 8), boff = lds_byte(wc * 32 + fr, fq * 8);
#define PG8_SA(b, h) (((b) * 2 + (h)) * HTB)
#define PG8_SB(b, h) ((4 + (b) * 2 + (h)) * HTB)
#define PG8_STAGE(bufoff, gbase, voff) do { _Pragma("unroll") for (int _i = 0; _i < 2; ++_i) \
        __builtin_amdgcn_global_load_lds((const unsigned*)((const char*)(gbase) + (voff)[_i]), (PG8_LAS unsigned*)(lds + (bufoff) + ldsw + _i * 8192), 16, 0, 0); } while (0)
#define PG8_LDA(dst, b, h) do { _Pragma("unroll") for (int m = 0; m < 4; ++m) _Pragma("unroll") for (int k = 0; k < 2; ++k) dst[m][k] = *(const PG8_LAS bf16x8*)(lds + PG8_SA(b, h) + aoff + m * 2048 + k * 1024); } while (0)
#define PG8_LDB(dst, b, h) do { _Pragma("unroll") for (int n = 0; n < 2; ++n) _Pragma("unroll") for (int k = 0; k < 2; ++k) dst[n][k] = *(const PG8_LAS bf16x8*)(lds + PG8_SB(b, h) + boff + n * 2048 + k * 1024); } while (0)
#define PG8_MMA(ai, bj, At, Bt) do { __builtin_amdgcn_s_setprio(1); _Pragma("unroll") for (int m = 0; m < 4; ++m) _Pragma("unroll") for (int n = 0; n < 2; ++n) _Pragma("unroll") for (int k = 0; k < 2; ++k) \
        acc[ai][bj][m][n] = __builtin_amdgcn_mfma_f32_16x16x32_bf16(Bt[n][k], At[m][k], acc[ai][bj][m][n], 0, 0, 0); __builtin_amdgcn_s_setprio(0); } while (0)
#define PG8_WAIT_V(n) asm volatile("s_waitcnt vmcnt(" #n ")" ::: "memory")
#define PG8_WAIT_L(n) asm volatile("s_waitcnt lgkmcnt(" #n ")" ::: "memory")
#define PG8_BAR __builtin_amdgcn_s_barrier()
#define PG8_SCHED __builtin_amdgcn_sched_barrier(0)
    Unit cur, nxt; int ui = 0;
    if (!S.next(0, cur)) return;
    f32x4 acc[2][2][4][2];
#pragma unroll
    for (int a = 0; a < 2; ++a)
#pragma unroll
        for (int b = 0; b < 2; ++b)
#pragma unroll
            for (int m = 0; m < 4; ++m)
#pragma unroll
                for (int n = 0; n < 2; ++n) acc[a][b][m][n] = (f32x4){0.f, 0.f, 0.f, 0.f};
    bf16x8 At[4][2], B0[2][2], B1[2][2];
    const char* cA = (const char*)g.A + (size_t)cur.pm * tstepA; const char* cB = (const char*)g.Bt + (size_t)cur.pn * tstepB;
    PG8_STAGE(PG8_SB(0, 0), cB, voffB); PG8_STAGE(PG8_SB(0, 1), cB + hstepB, voffB); PG8_STAGE(PG8_SA(0, 0), cA, voffA); PG8_STAGE(PG8_SA(0, 1), cA + hstepA, voffA);
    if (wr == 1) PG8_BAR;
    PG8_WAIT_V(2); PG8_BAR;
    PG8_STAGE(PG8_SB(1, 0), cB + kstep, voffB); PG8_STAGE(PG8_SA(1, 0), cA + kstep, voffA); PG8_STAGE(PG8_SB(1, 1), cB + hstepB + kstep, voffB);
    PG8_WAIT_V(6); PG8_BAR;
    for (;;) {
        const bool has_next = S.next(ui + 1, nxt);
        const char* nA = has_next ? (const char*)g.A + (size_t)nxt.pm * tstepA : cA; const char* nB = has_next ? (const char*)g.Bt + (size_t)nxt.pn * tstepB : cB;
        for (int t = 0; t < nt; t += 2) {
            const bool last = (t == nt - 2);
            const char* a1 = cA + (size_t)(t + 1) * kstep;
            const char* a2 = last ? nA : cA + (size_t)(t + 2) * kstep; const char* b2 = last ? nB : cB + (size_t)(t + 2) * kstep;
            const char* a3 = a2 + kstep; const char* b3 = b2 + kstep;
            PG8_LDB(B0, 0, 0); PG8_LDB(B1, 0, 1); PG8_SCHED; PG8_LDA(At, 0, 0); PG8_STAGE(PG8_SA(1, 1), a1 + hstepA, voffA);
            PG8_WAIT_V(8); PG8_WAIT_L(0); PG8_BAR; PG8_MMA(0, 0, At, B0); PG8_MMA(0, 1, At, B1); PG8_BAR; PG8_SCHED;
            PG8_LDA(At, 0, 1); PG8_STAGE(PG8_SB(0, 0), b2, voffB); PG8_STAGE(PG8_SB(0, 1), b2 + hstepB, voffB); PG8_STAGE(PG8_SA(0, 0), a2, voffA);
            PG8_WAIT_V(8); PG8_WAIT_L(0); PG8_BAR; PG8_MMA(1, 0, At, B0); PG8_MMA(1, 1, At, B1); PG8_BAR; PG8_SCHED;
            PG8_LDB(B0, 1, 0); PG8_LDB(B1, 1, 1); PG8_SCHED; PG8_LDA(At, 1, 0); PG8_STAGE(PG8_SA(0, 1), a2 + hstepA, voffA);
            PG8_WAIT_V(8); PG8_WAIT_L(0); PG8_BAR; PG8_MMA(0, 0, At, B0); PG8_MMA(0, 1, At, B1); PG8_BAR; PG8_SCHED;
            PG8_LDA(At, 1, 1); PG8_STAGE(PG8_SB(1, 0), b3, voffB); PG8_STAGE(PG8_SB(1, 1), b3 + hstepB, voffB); PG8_STAGE(PG8_SA(1, 0), a3, voffA);
            PG8_WAIT_V(8); PG8_WAIT_L(0); PG8_BAR; PG8_MMA(1, 0, At, B0); PG8_MMA(1, 1, At, B1); PG8_BAR; PG8_SCHED;
        }
        if (wr == 0) PG8_BAR;
        E(acc, cur, wr, wc, fr, fq);
        if (!has_next) break;
#pragma unroll
        for (int a = 0; a < 2; ++a)
#pragma unroll
            for (int b = 0; b < 2; ++b)
#pragma unroll
                for (int m = 0; m < 4; ++m)
#pragma unroll
                    for (int n = 0; n < 2; ++n) acc[a][b][m][n] = (f32x4){0.f, 0.f, 0.f, 0.f};
        cur = nxt; cA = nA; cB = nB; ++ui;
        if (wr == 1) PG8_BAR;
    }
    PG8_WAIT_V(0);
    PG8_BAR;
#undef PG8_SA
#undef PG8_SB
#undef PG8_STAGE
#undef PG8_LDA
#undef PG8_LDB
#undef PG8_MMA
#undef PG8_WAIT_V
#undef PG8_WAIT_L
#undef PG8_BAR
#undef PG8_SCHED
}
}

typedef f32x4 AccT[2][2][4][2];
DEV u32x4 pack8(const f32x4& a, const f32x4& b) { u32x4 w; w.x = pk_bf16(a[0], a[1]); w.y = pk_bf16(a[2], a[3]); w.z = pk_bf16(b[0], b[1]); w.w = pk_bf16(b[2], b[3]); return w; }

struct EpiPlain {
    bf16_t* C; int ldc; int kd;
    DEV void operator()(const AccT& acc, const pg8::Unit& u, int wr, int wc, int fr, int fq) const {
        const int row0 = u.pm * 256 + wr * 64 + fr, col0 = u.pn * 256 + wc * 32 + 8 * fq;
#pragma unroll
        for (int ai = 0; ai < 2; ++ai)
#pragma unroll
            for (int m = 0; m < 4; ++m) {
                bf16_t* rowp = C + (size_t)(row0 + ai * 128 + m * 16) * ldc;
#pragma unroll
                for (int bj = 0; bj < 2; ++bj) { int col = col0 + bj * 128; if (kd) col = (col >> 6) * 96 + (col & 63);
                    *(u32x4*)(rowp + col) = pack8(acc[ai][bj][m][0], acc[ai][bj][m][1]); }
            }
    }
};
struct EpiResid {
    const float* xin; float* xout;
    DEV void operator()(const AccT& acc, const pg8::Unit& u, int wr, int wc, int fr, int fq) const {
        const int row0 = u.pm * 256 + wr * 64 + fr, col0 = u.pn * 256 + wc * 32 + 8 * fq;
#pragma unroll
        for (int ai = 0; ai < 2; ++ai)
#pragma unroll
            for (int m = 0; m < 4; ++m) {
                const size_t ro = (size_t)(row0 + ai * 128 + m * 16) * DM;
#pragma unroll
                for (int bj = 0; bj < 2; ++bj) { const size_t o = ro + col0 + bj * 128;
                    const f32x4 x0 = *(const f32x4*)(xin + o), x1 = *(const f32x4*)(xin + o + 4);
                    *(f32x4*)(xout + o) = x0 + acc[ai][bj][m][0]; *(f32x4*)(xout + o + 4) = x1 + acc[ai][bj][m][1]; }
            }
    }
};
struct EpiSwiglu {
    bf16_t* ACT;
    DEV void operator()(const AccT& acc, const pg8::Unit& u, int wr, int wc, int fr, int fq) const {
        const int row0 = u.pm * 256 + wr * 64 + fr, col0 = u.pn * 128 + wc * 32 + 8 * fq;
#pragma unroll
        for (int ai = 0; ai < 2; ++ai)
#pragma unroll
            for (int m = 0; m < 4; ++m) {
                f32x4 o[2];
#pragma unroll
                for (int n = 0; n < 2; ++n)
#pragma unroll
                    for (int j = 0; j < 4; ++j) { const float gv = acc[ai][0][m][n][j], uv = acc[ai][1][m][n][j]; o[n][j] = gv / (1.0f + __expf(-gv)) * uv; }
                *(u32x4*)(ACT + (size_t)(row0 + ai * 128 + m * 16) * DFF + col0) = pack8(o[0], o[1]);
            }
    }
};
struct EpiVT {
    bf16_t* VT; int head_base;
    DEV void operator()(const AccT& acc, const pg8::Unit& u, int wr, int wc, int fr, int fq) const {
        const int r0 = u.pm * 256 + wr * 64 + fr, c0 = u.pn * 256 + wc * 32 + 8 * fq;
#pragma unroll
        for (int ai = 0; ai < 2; ++ai)
#pragma unroll
            for (int m = 0; m < 4; ++m) {
                const int r = r0 + ai * 128 + m * 16, head = head_base + (r >> 6), d = r & 63;
#pragma unroll
                for (int bj = 0; bj < 2; ++bj) { const int c = c0 + bj * 128, b = c >> 12, sq = c & 4095;
                    *(u32x4*)(VT + ((size_t)((b * 16 + head) * 64 + d)) * 4096 + sq) = pack8(acc[ai][bj][m][0], acc[ai][bj][m][1]); }
            }
    }
};
template <class Epi>
DEV void run_gemm(char* smem, const bf16_t* A, int ldA, int M, const bf16_t* Bt, int ldB, int N, int K, const Epi& E) {
    __syncthreads();
    pg8::Gemm g{A, Bt, M, N, K, ldA, ldB}; pg8::StaticOrder S; S.init(M, N, (int)gridDim.x, BID);
    pg8::gemm_phase<Epi>((PG8_LAS unsigned char*)smem, g, S, E);
    __syncthreads();
}

template <int LPR, bool MEAN>
DEV void rownorm_block(bf16_t* buf, int ld, int col0, const float* __restrict__ gain, int row0, float* kmean_out, float* red) {
    constexpr int RPI = NT / LPR;
    const int tid = TID, sub = tid % LPR, rr = tid / LPR;
    float g[8], am[8];
#pragma unroll
    for (int i = 0; i < 8; ++i) { g[i] = gain[sub * 8 + i]; am[i] = 0.f; }
    for (int it = 0; it < 256 / RPI; ++it) {
        bf16_t* rp = buf + (size_t)(row0 + it * RPI + rr) * ld + col0 + sub * 8;
        const u32x4 v = *(const u32x4*)rp;
        float x[8] = {bf_lo(v.x), bf_hi(v.x), bf_lo(v.y), bf_hi(v.y), bf_lo(v.z), bf_hi(v.z), bf_lo(v.w), bf_hi(v.w)};
        float ss = 0.f;
#pragma unroll
        for (int i = 0; i < 8; ++i) ss += x[i] * x[i];
#pragma unroll
        for (int o = 1; o < LPR; o <<= 1) ss += __shfl_xor(ss, o);
        const float rstd = rsqrtf(ss * (1.0f / (LPR * 8)) + EPS);
#pragma unroll
        for (int i = 0; i < 8; ++i) { x[i] = x[i] * rstd * g[i]; if (MEAN) am[i] += x[i]; }
        u32x4 o; o.x = pk_bf16(x[0], x[1]); o.y = pk_bf16(x[2], x[3]); o.z = pk_bf16(x[4], x[5]); o.w = pk_bf16(x[6], x[7]);
        *(u32x4*)rp = o;
    }
    if (MEAN) {
        __syncthreads();
#pragma unroll
        for (int i = 0; i < 8; ++i) red[rr * 64 + sub * 8 + i] = am[i];
        __syncthreads();
        if (tid < 64) {
            float s = 0.f;
            for (int r = 0; r < RPI; ++r) s += red[r * 64 + tid];
            kmean_out[tid] = s * (1.0f / 256.0f);
        }
    }
}

DEV void even_post(const Params& p, int li, char* smem) {
    char* ws = p.ws;
    bf16_t* EB = (bf16_t*)(ws + OFF_EB);
    float* red = (float*)smem;
    for (int it = BID; it < 2048 + 64; it += gridDim.x) {
        if (it < 2048) {
            const int blk = it >> 4, hh = it & 15;
            rownorm_block<8, false>(EB, 2048, hh * 64, (hh < 8 ? p.ev_qn : p.ev_kn) + li * 64, blk * 256, nullptr, red);
        } else {
            const int bh = it - 2048, b = bh >> 3, h = bh & 7, tid = TID, lane = tid & 63, wid = tid >> 6;
            const float* FA = (const float*)(ws + OFF_FA);
            float* CD = (float*)(ws + OFF_CDEC) + (size_t)bh * 4096;
            const float fb = p.ev_fb[li * 8 + h];
            float lf[8]; float run = 0.f;
#pragma unroll
            for (int i = 0; i < 8; ++i) {
                const float z = FA[(size_t)(b * 4096 + tid * 8 + i) * 8 + h] + fb;
                const float ls = fminf(z, 0.f) - log1pf(expf(-fabsf(z)));
                run += ls; lf[i] = run;
            }
            float inc = run;
#pragma unroll
            for (int o = 1; o < 64; o <<= 1) { const float y = __shfl_up(inc, o); if (lane >= o) inc += y; }
            __syncthreads();
            if (lane == 63) red[wid] = inc;
            __syncthreads();
            float base = inc - run;
            for (int w = 0; w < wid; ++w) base += red[w];
#pragma unroll
            for (int i = 0; i < 8; ++i) CD[tid * 8 + i] = (base + lf[i]) * LOG2E;
            __syncthreads();
        }
    }
}

DEV void odd_post1(const Params& p, int li, char* smem) {
    char* ws = p.ws;
    bf16_t* OB = (bf16_t*)(ws + OFF_EB);
    float* red = (float*)smem;
    float* KM = (float*)(ws + OFF_KMEAN);
    for (int it = BID; it < 2304; it += gridDim.x) {
        if (it < 1024) {
            const int blk = it >> 3, h = it & 7, b = blk >> 4, nb = blk & 15;
            rownorm_block<8, true>(OB, 1536, 512 + h * 64, p.od_mkn + li * 64, blk * 256, KM + (size_t)((b * 8 + h) * 16 + nb) * 64, red);
            __syncthreads();
        } else if (it < 2048) {
            const int j = it - 1024, blk = j >> 3, h = j & 7;
            rownorm_block<8, false>(OB, 1536, h * 64, p.od_mqn + li * 64, blk * 256, nullptr, red);
        } else if (it < 2176) {
            rownorm_block<32, false>(OB, 1536, 1024, p.od_qan + li * 256, (it - 2048) * 256, nullptr, red);
        } else {
            rownorm_block<16, false>(OB, 1536, 1280, p.od_kvan + li * 128, (it - 2176) * 256, nullptr, red);
        }
    }
}

DEV void moba_gate(const Params& p) {
    char* ws = p.ws;
    const bf16_t* OB = (const bf16_t*)(ws + OFF_EB);
    const float* KM = (const float*)(ws + OFF_KMEAN);
    int* SEL = (int*)(ws + OFF_SEL);
    const int gt = BID * blockDim.x + TID, gn = gridDim.x * blockDim.x;
    for (int w = gt; w < 8 * M_TOK; w += gn) {
        const int h = w >> 15, token = w & (M_TOK - 1), b = token >> 12, s = token & 4095, cur = s >> 8;
        float q[64];
        const u32x4* qp = (const u32x4*)(OB + (size_t)token * 1536 + h * 64);
#pragma unroll
        for (int i = 0; i < 8; ++i) { const u32x4 v = qp[i]; q[8 * i] = bf_lo(v.x); q[8 * i + 1] = bf_hi(v.x); q[8 * i + 2] = bf_lo(v.y); q[8 * i + 3] = bf_hi(v.y);
            q[8 * i + 4] = bf_lo(v.z); q[8 * i + 5] = bf_hi(v.z); q[8 * i + 6] = bf_lo(v.w); q[8 * i + 7] = bf_hi(v.w); }
        float v1 = -INFINITY, v2 = -INFINITY, v3 = -INFINITY; int i1 = -1, i2 = -1, i3 = -1;
        const float* kmb = KM + (size_t)((b * 8 + h) * 16) * 64;
        for (int n = 0; n < cur; ++n) {
            const f32x4* km = (const f32x4*)(kmb + n * 64);
            float d = 0.f;
#pragma unroll
            for (int i = 0; i < 16; ++i) { const f32x4 k4 = km[i]; d += q[4 * i] * k4[0] + q[4 * i + 1] * k4[1] + q[4 * i + 2] * k4[2] + q[4 * i + 3] * k4[3]; }
            if (d > v1) { v3 = v2; i3 = i2; v2 = v1; i2 = i1; v1 = d; i1 = n; }
            else if (d > v2) { v3 = v2; i3 = i2; v2 = d; i2 = n; }
            else if (d > v3) { v3 = d; i3 = n; }
        }
        int m = 0;
        if (i1 >= 0) m |= 1 << i1;
        if (i2 >= 0) m |= 1 << i2;
        if (i3 >= 0) m |= 1 << i3;
        SEL[(size_t)(b * 8 + h) * 4096 + s] = m;
    }
}

DEV void mla_post(const Params& p, int li) {
    char* ws = p.ws;
    bf16_t* QD = (bf16_t*)(ws + OFF_QD);
    bf16_t* KD = (bf16_t*)(ws + OFF_KD);
    const bf16_t* OB = (const bf16_t*)(ws + OFF_EB);
    const float* rope = (const float*)(ws + OFF_ROPE);
    const int gt = BID * blockDim.x + TID, gn = gridDim.x * blockDim.x;
    for (int w = gt; w < 2 * 8 * M_TOK; w += gn) {
        const int isk = w >> 18, rem = w & ((1 << 18) - 1), token = rem >> 3, h = rem & 7, s = token & 4095;
        bf16_t* rp = (isk ? KD : QD) + (size_t)token * 768 + h * 96;
        const float* gain = (isk ? p.od_lkn : p.od_lqn) + li * 96;
        float x[96];
#pragma unroll
        for (int i = 0; i < 12; ++i) {
            u32x4 v;
            if (isk && i >= 8) v = *(const u32x4*)(OB + (size_t)token * 1536 + 1408 + (i - 8) * 8);
            else v = *(const u32x4*)(rp + i * 8);
            x[8 * i] = bf_lo(v.x); x[8 * i + 1] = bf_hi(v.x); x[8 * i + 2] = bf_lo(v.y); x[8 * i + 3] = bf_hi(v.y);
            x[8 * i + 4] = bf_lo(v.z); x[8 * i + 5] = bf_hi(v.z); x[8 * i + 6] = bf_lo(v.w); x[8 * i + 7] = bf_hi(v.w);
        }
        float ss = 0.f;
#pragma unroll
        for (int i = 0; i < 96; ++i) ss += x[i] * x[i];
        const float rstd = rsqrtf(ss * (1.0f / 96.0f) + EPS);
#pragma unroll
        for (int i = 0; i < 96; ++i) x[i] = x[i] * rstd * gain[i];
        const float* cs = rope + (size_t)s * 16;
        const float* sn = rope + 4096 * 16 + (size_t)s * 16;
#pragma unroll
        for (int i = 0; i < 16; ++i) {
            const float c = cs[i], sv = sn[i], a = x[64 + i], bb = x[80 + i];
            x[64 + i] = a * c - bb * sv; x[80 + i] = a * sv + bb * c;
        }
#pragma unroll
        for (int i = 0; i < 12; ++i) {
            u32x4 o; o.x = pk_bf16(x[8 * i], x[8 * i + 1]); o.y = pk_bf16(x[8 * i + 2], x[8 * i + 3]); o.z = pk_bf16(x[8 * i + 4], x[8 * i + 5]); o.w = pk_bf16(x[8 * i + 6], x[8 * i + 7]);
            *(u32x4*)(rp + i * 8) = o;
        }
    }
}

enum { AT_FOX = 0, AT_SB, AT_MOBA, AT_MLA };
constexpr int AT_KBUF = 13312, AT_VBUF = 8192, AT_K0 = 0, AT_V0 = 2 * AT_KBUF, AT_MISC = AT_V0 + 2 * AT_VBUF, AT_CK = AT_MISC + 1024;

template <int MODE>
DEV void attn_item(const Params& p, char* smem, int b, int h, int qt, int li) {
    constexpr int DQK = (MODE == AT_MLA) ? 96 : 64;
    constexpr int NKS = DQK / 32;
    constexpr int KSTRB = (DQK + 8) * 2;
    constexpr int KCH = DQK / 8;
    constexpr int KLD = (64 * KCH + NT - 1) / NT;
    char* ws = p.ws;
    const int tid = TID, wid = tid >> 6, lane = tid & 63, fr = lane & 15, fq = lane >> 4;
    const bf16_t* Qb; const bf16_t* Kb; int ldq; int head16;
    if (MODE == AT_FOX) { Qb = (const bf16_t*)(ws + OFF_EB) + h * 64; Kb = Qb + 512; ldq = 2048; head16 = h; }
    else if (MODE == AT_SB) { Qb = (const bf16_t*)(ws + OFF_EB) + 1024 + h * 64; Kb = Qb + 512; ldq = 2048; head16 = 8 + h; }
    else if (MODE == AT_MOBA) { Qb = (const bf16_t*)(ws + OFF_EB) + h * 64; Kb = Qb + 512; ldq = 1536; head16 = h; }
    else { Qb = (const bf16_t*)(ws + OFF_QD) + h * 96; Kb = (const bf16_t*)(ws + OFF_KD) + h * 96; ldq = 768; head16 = 8 + h; }
    const bf16_t* Vt = (const bf16_t*)(ws + OFF_VT) + (size_t)((b * 16 + head16) * 64) * 4096;
    const size_t tokb = (size_t)b * 4096;
    const int qw0 = qt * 128 + wid * 16;
    const int qpos = qw0 + fr;
    const int tlast = 2 * qt + 1;
    int* smi = (int*)(smem + AT_MISC);
    float* btab = (float*)(smem + AT_MISC + 512);

    __syncthreads();
    int mysel = 0;
    if (MODE == AT_MOBA) {
        mysel = ((const int*)(ws + OFF_SEL))[(size_t)(b * 8 + h) * 4096 + qpos];
        if (tid == 0) smi[73] = 0;
        if (tid < 128) btab[tid] = ((const float*)(ws + OFF_BTAB))[h * 128 + tid];
        __syncthreads();
        if (fq == 0) atomicOr(&smi[73], mysel);
        __syncthreads();
    }
    if (tid == 0) {
        int n = 0;
        if (MODE == AT_MLA) { for (int t = 0; t <= tlast; ++t) smi[n++] = t; }
        else if (MODE == AT_SB || MODE == AT_FOX) { for (int t = tlast; t >= 0; --t) smi[n++] = t; }
        else {
            const int cur = qt >> 1, um = smi[73];
            for (int t = cur * 4; t <= tlast; ++t) smi[n++] = t;
            for (int kb = 0; kb < cur; ++kb) if ((um >> kb) & 1) { for (int t = 0; t < 4; ++t) smi[n++] = kb * 4 + t; }
        }
        smi[72] = n;
    }
    __syncthreads();
    const int nt = smi[72];

    bf16x8 qf[NKS];
    {
        const bf16_t* qp = Qb + (tokb + qpos) * ldq + fq * 8;
#pragma unroll
        for (int ks = 0; ks < NKS; ++ks) qf[ks] = *(const bf16x8*)(qp + ks * 32);
    }
    float cq = 0.f;
    const float* CD = (const float*)(ws + OFF_CDEC) + (size_t)(b * 8 + h) * 4096;
    float sbound = 0.f;
    int wsel = 0;
    if (MODE == AT_FOX) {
        cq = CD[qpos];
        float gq = fabsf(p.ev_qn[li * 64 + lane]), gk = fabsf(p.ev_kn[li * 64 + lane]);
#pragma unroll
        for (int o_ = 32; o_ > 0; o_ >>= 1) { gq = fmaxf(gq, __shfl_xor(gq, o_)); gk = fmaxf(gk, __shfl_xor(gk, o_)); }
        sbound = 8.0f * gq * gk * LOG2E * 1.02f;
    }
    if (MODE == AT_MOBA) {
        wsel = mysel;
#pragma unroll
        for (int o_ = 32; o_ > 0; o_ >>= 1) wsel |= __shfl_xor(wsel, o_);
    }
    const float c1 = (MODE == AT_MLA ? 0.10206207261596577f : 0.125f) * (MODE == AT_SB ? 1.0f : LOG2E);
    const float bfar = (MODE == AT_MOBA) ? btab[127] : 0.f;

    f32x4 o[4];
#pragma unroll
    for (int i = 0; i < 4; ++i) o[i] = (f32x4){0.f, 0.f, 0.f, 0.f};
    float mrun = -1e30f, lsum = 0.f, R = 0.f;

    u32x4 rk[KLD], rv; f32x4 rc = (f32x4){0.f, 0.f, 0.f, 0.f};
    auto gload = [&](int tile) {
        if (MODE == AT_FOX) { if (tid < 16) rc = *(const f32x4*)(CD + tile * 64 + tid * 4); }
#pragma unroll
        for (int i = 0; i < KLD; ++i) { const int idx = tid + NT * i, r = idx / KCH, c = idx % KCH; if (idx < 64 * KCH) rk[i] = *(const u32x4*)(Kb + (tokb + tile * 64 + r) * ldq + c * 8); }
        { const int d = tid >> 3, c8 = tid & 7; rv = *(const u32x4*)(Vt + (size_t)d * 4096 + tile * 64 + c8 * 8); }
    };
    auto lstore = [&](int buf) {
        char* kb = smem + AT_K0 + buf * AT_KBUF; char* vb = smem + AT_V0 + buf * AT_VBUF;
        if (MODE == AT_FOX) { if (tid < 16) *(f32x4*)(smem + AT_CK + buf * 256 + tid * 16) = rc; }
#pragma unroll
        for (int i = 0; i < KLD; ++i) { const int idx = tid + NT * i, r = idx / KCH, c = idx % KCH; if (idx < 64 * KCH) *(u32x4*)(kb + r * KSTRB + c * 16) = rk[i]; }
        { const int d = tid >> 3, c8 = tid & 7; *(u32x4*)(vb + ((c8 >> 1) * 64 + d) * 32 + (c8 & 1) * 16) = rv; }
    };
    gload(smi[0]); lstore(0);
    __syncthreads();
    for (int it = 0; it < nt; ++it) {
        const int tile = smi[it], buf = it & 1;
        const bool more = it + 1 < nt;
        if (more) gload(smi[it + 1]);
        const char* kb = smem + AT_K0 + buf * AT_KBUF; const char* vb = smem + AT_V0 + buf * AT_VBUF;
        const int kbase = tile * 64 + fq * 4;
        bool wave_live = (MODE == AT_SB) ? (tile * 64 < qw0 + 15) : (tile * 64 <= qw0 + 15);
        if (MODE == AT_MOBA) { if ((tile >> 2) != (qt >> 1)) wave_live = (wsel >> (tile >> 2)) & 1; }
        float cnext = 0.f;
        if (MODE == AT_FOX) { if (tile > 0) cnext = CD[tile * 64 - 1]; }
        const bool diag = (tile * 64 + 63 >= qw0);
        if (wave_live) {
        f32x4 s[4];
#pragma unroll
        for (int kt = 0; kt < 4; ++kt) {
            s[kt] = (f32x4){0.f, 0.f, 0.f, 0.f};
#pragma unroll
            for (int ks = 0; ks < NKS; ++ks) {
                const bf16x8 kf = *(const bf16x8*)(kb + (kt * 16 + fr) * KSTRB + (ks * 32 + fq * 8) * 2);
                s[kt] = __builtin_amdgcn_mfma_f32_16x16x32_bf16(kf, qf[ks], s[kt], 0, 0, 0);
            }
        }
        const bool far_tile = (MODE == AT_MOBA) && (qt * 128 - (tile * 64 + 63) >= 127);
        unsigned pp[4][2];
        if (MODE == AT_SB) {
            float T[4], exq[4], ls[4][4], e[4][4];
#pragma unroll
            for (int kt = 0; kt < 4; ++kt) {
                float v[4];
#pragma unroll
                for (int j = 0; j < 4; ++j) {
                    const float z = s[kt][j] * c1;
                    const float sp = __logf(1.0f + __expf(-fabsf(z)));
                    const float l = fminf(z, 0.f) - sp;
                    const bool strict = !diag || (kbase + kt * 16 + j < qpos);
                    ls[kt][j] = strict ? l : -INFINITY;
                    v[j] = strict ? (l - z) : 0.f;
                }
                e[kt][3] = 0.f; e[kt][2] = v[3]; e[kt][1] = v[3] + v[2]; e[kt][0] = e[kt][1] + v[1];
                const float G = e[kt][0] + v[0];
                float xs = G;
                float y = __shfl_down(xs, 16); if (fq < 3) xs += y;
                y = __shfl_down(xs, 32); if (fq < 2) xs += y;
                exq[kt] = xs - G;
                T[kt] = __shfl(xs, fr);
            }
            float off = R;
#pragma unroll
            for (int kt = 3; kt >= 0; --kt) {
                float w[4];
#pragma unroll
                for (int j = 0; j < 4; ++j) w[j] = __expf(ls[kt][j] + off + exq[kt] + e[kt][j]);
                pp[kt][0] = pk_bf16(w[0], w[1]); pp[kt][1] = pk_bf16(w[2], w[3]);
                off += T[kt];
            }
            R = off;
        } else {
            float t[4][4];
            float mx = -1e30f;
            auto logits = [&](auto MASKED) {
                constexpr bool MSK = decltype(MASKED)::value;
#pragma unroll
                for (int kt = 0; kt < 4; ++kt) {
                    f32x4 bias = (f32x4){0.f, 0.f, 0.f, 0.f};
                    if (MODE == AT_FOX) { const f32x4 ck = *(const f32x4*)(smem + AT_CK + buf * 256 + (kt * 16 + fq * 4) * 4); bias = (f32x4){cq, cq, cq, cq} - ck; }
                    bool blk_ok = true;
                    if (MODE == AT_MOBA) {
                        blk_ok = (tile >> 2) == (qt >> 1) || ((mysel >> (tile >> 2)) & 1);
                        if (far_tile) { bias = (f32x4){bfar, bfar, bfar, bfar}; }
                        else {
#pragma unroll
                            for (int j = 0; j < 4; ++j) { int dist = qpos - (kbase + kt * 16 + j); dist = dist < 0 ? 0 : (dist > 127 ? 127 : dist); bias[j] = btab[dist]; }
                        }
                    }
#pragma unroll
                    for (int j = 0; j < 4; ++j) {
                        float v = s[kt][j] * c1 + bias[j];
                        if (MSK) { const bool ok = blk_ok && (kbase + kt * 16 + j <= qpos); v = ok ? v : -1e30f; }
                        else if (MODE == AT_MOBA) { v = blk_ok ? v : -1e30f; }
                        t[kt][j] = v; mx = fmaxf(mx, v);
                    }
                }
            };
            if (diag) logits(std::true_type{}); else logits(std::false_type{});
            mx = fmaxf(mx, __shfl_xor(mx, 16)); mx = fmaxf(mx, __shfl_xor(mx, 32));
            const float mnew = fmaxf(mrun, mx);
            const float alpha = __builtin_amdgcn_exp2f(mrun - mnew);
            mrun = mnew;
            float ps = 0.f;
#pragma unroll
            for (int kt = 0; kt < 4; ++kt) {
                float w[4];
#pragma unroll
                for (int j = 0; j < 4; ++j) { w[j] = __builtin_amdgcn_exp2f(t[kt][j] - mnew); ps += w[j]; }
                pp[kt][0] = pk_bf16(w[0], w[1]); pp[kt][1] = pk_bf16(w[2], w[3]);
            }
            lsum = lsum * alpha + ps;
#pragma unroll
            for (int i = 0; i < 4; ++i) o[i] = o[i] * alpha;
        }
#pragma unroll
        for (int kk = 0; kk < 2; ++kk) {
            u32x4 pw; pw.x = pp[2 * kk][0]; pw.y = pp[2 * kk][1]; pw.z = pp[2 * kk + 1][0]; pw.w = pp[2 * kk + 1][1];
            const bf16x8 pf = __builtin_bit_cast(bf16x8, pw);
#pragma unroll
            for (int dt = 0; dt < 4; ++dt) {
                const u32x2 lo = *(const u32x2*)(vb + ((2 * kk) * 64 + dt * 16 + fr) * 32 + fq * 8);
                const u32x2 hi = *(const u32x2*)(vb + ((2 * kk + 1) * 64 + dt * 16 + fr) * 32 + fq * 8);
                u32x4 vw; vw.x = lo.x; vw.y = lo.y; vw.z = hi.x; vw.w = hi.y;
                o[dt] = __builtin_amdgcn_mfma_f32_16x16x32_bf16(__builtin_bit_cast(bf16x8, vw), pf, o[dt], 0, 0, 0);
            }
        }
        }
        if (more) lstore(buf ^ 1);
        if (MODE == AT_SB) {
            if (__syncthreads_and(R < -40.0f)) break;
        } else if (MODE == AT_FOX) {
            if (__syncthreads_and(tile == 0 || (sbound + cq - cnext < mrun - 40.0f))) break;
        } else {
            __syncthreads();
        }
    }
    float inv = 1.0f;
    if (MODE != AT_SB) {
        float l = lsum; l += __shfl_xor(l, 16); l += __shfl_xor(l, 32);
        inv = 1.0f / l;
    }
    bf16_t* op = (bf16_t*)(ws + OFF_HM) + (tokb + qpos) * 1024 + head16 * 64 + fq * 4;
#pragma unroll
    for (int dt = 0; dt < 4; ++dt) {
        u32x2 w; w.x = pk_bf16(o[dt][0] * inv, o[dt][1] * inv); w.y = pk_bf16(o[dt][2] * inv, o[dt][3] * inv);
        *(u32x2*)(op + dt * 16) = w;
    }
}

DEV void attn_phase(const Params& p, char* smem, bool even, unsigned* ctr, int li) {
    int* smi = (int*)(smem + AT_MISC);
    const int tid = TID;
    for (;;) {
        __syncthreads();
        if (tid == 0) smi[74] = (int)__hip_atomic_fetch_add(ctr, 1u, __ATOMIC_RELAXED, __HIP_MEMORY_SCOPE_AGENT);
        __syncthreads();
        const int it = smi[74];
        if (it >= 32 * 128) break;
        const int qt = 31 - (it >> 7), bh = it & 127, b = bh >> 4, h16 = bh & 15;
        if (even) { if (h16 < 8) attn_item<AT_FOX>(p, smem, b, h16, qt, li); else attn_item<AT_SB>(p, smem, b, h16 - 8, qt, li); }
        else { if (h16 < 8) attn_item<AT_MOBA>(p, smem, b, h16, qt, li); else attn_item<AT_MLA>(p, smem, b, h16 - 8, qt, li); }
    }
}

DEV void gsync(unsigned* ctr, unsigned& target) {
    asm volatile("s_waitcnt vmcnt(0) lgkmcnt(0)" ::: "memory");
    __syncthreads();
    target += gridDim.x;
    if (threadIdx.x == 0) {
        __builtin_amdgcn_fence(__ATOMIC_RELEASE, "agent");
        __hip_atomic_fetch_add(ctr, 1u, __ATOMIC_RELAXED, __HIP_MEMORY_SCOPE_AGENT);
        while (__hip_atomic_load(ctr, __ATOMIC_RELAXED, __HIP_MEMORY_SCOPE_AGENT) < target) __builtin_amdgcn_s_sleep(1);
        __builtin_amdgcn_fence(__ATOMIC_ACQUIRE, "agent");
    }
    __syncthreads();
}

enum { OP_NORM_MIX = 0, OP_GEMM_IN, OP_EPOST, OP_OPOST1, OP_GEMM_QB, OP_GEMM_KVB, OP_GATE, OP_MLAPOST, OP_ATTN, OP_GEMM_OUT, OP_NORM_FFN, OP_GEMM_GU, OP_GEMM_DN };

__global__ void __launch_bounds__(512) fwd_megakernel(Params p) {
    extern __shared__ __attribute__((aligned(16))) char smem[];
    cg::grid_group grid = cg::this_grid();
    char* ws = p.ws;
    unsigned* bar = (unsigned*)(ws + OFF_BAR);
    unsigned btarget = 0;
    grid.sync();
    for (int rep = 0; rep < DBG_REP_SMALL; ++rep) prologue(p, smem);
    gsync(bar, btarget);
    for (int gs = 0; gs < 40; ++gs) {
        {
            const int gq = opq_s(gs);
#ifdef DBG_STEPS
            if (gq >= DBG_STEPS) break;
#endif
            const int pair = gq / 20, rr20 = gq - pair * 20;
            const bool even = rr20 < 8;
            const int step = even ? rr20 : rr20 - 8;
            const int layer = pair * 2 + (even ? 0 : 1), li = pair;
            const float* xin = layer == 0 ? p.x : p.out;
            int op; bool sync = true;
            if (even) {
                switch (step) { case 0: op = OP_NORM_MIX; break; case 1: op = OP_GEMM_IN; break; case 2: op = OP_EPOST; break; case 3: op = OP_ATTN; break;
                                case 4: op = OP_GEMM_OUT; break; case 5: op = OP_NORM_FFN; break; case 6: op = OP_GEMM_GU; break; default: op = OP_GEMM_DN; break; }
            } else {
                switch (step) { case 0: op = OP_NORM_MIX; break; case 1: op = OP_GEMM_IN; break; case 2: op = OP_OPOST1; break; case 3: op = OP_GEMM_QB; break;
                                case 4: op = OP_GEMM_KVB; break; case 5: op = OP_GATE; break; case 6: op = OP_MLAPOST; break; case 7: op = OP_ATTN; break;
                                case 8: op = OP_GEMM_OUT; break; case 9: op = OP_NORM_FFN; break; case 10: op = OP_GEMM_GU; break; default: op = OP_GEMM_DN; break; }
            }
            if (op == OP_GEMM_QB || op == OP_GEMM_KVB) sync = false;
            bool jp = false, jv = false, jr = false, jg = false;
            const bf16_t *pA = nullptr, *pB = nullptr, *vA = nullptr, *vB = nullptr, *rA = nullptr, *rB = nullptr;
            int pldA = 0, pN = 0, pK = 0, vM = 0, vldB = 0, vK = 0, rK = 0, vhead = 0;
            EpiPlain eP{nullptr, 0, 0}; const float* rxin = nullptr;
            switch (op) {
            case OP_NORM_MIX: for (int rep = 0; rep < DBG_REP_SMALL; ++rep) norm_phase(xin, (even ? p.ev_norm : p.od_norm) + li * DM, (bf16_t*)(ws + OFF_HM), even ? p.ev_w_in + (size_t)li * 1024 * 3080 : nullptr, (float*)(ws + OFF_FA), smem); break;
            case OP_NORM_FFN: for (int rep = 0; rep < DBG_REP_SMALL; ++rep) norm_phase(p.out, p.ffn_norm + layer * DM, (bf16_t*)(ws + OFF_HM), nullptr, nullptr, smem); break;
            case OP_EPOST: even_post(p, li, smem); break;
            case OP_OPOST1: odd_post1(p, li, smem); break;
            case OP_GATE: for (int rep = 0; rep < DBG_REP_SMALL; ++rep) moba_gate(p); break;
            case OP_MLAPOST: mla_post(p, li); break;
            case OP_ATTN: attn_phase(p, smem, even, bar + 16 + layer, li); break;
            case OP_GEMM_IN:
                jp = jv = true; pA = (const bf16_t*)(ws + OFF_HM); pldA = 1024; pK = 1024; vB = pA; vldB = 1024; vK = 1024; vhead = 0;
                if (even) { pB = (const bf16_t*)(ws + OFF_EVIN) + li * SZ_EVIN; pN = 2048; eP = EpiPlain{(bf16_t*)(ws + OFF_EB), 2048, 0}; vA = pB + (size_t)2048 * 1024; vM = 1024; }
                else { pB = (const bf16_t*)(ws + OFF_ODIN) + li * SZ_ODIN; pN = 1536; eP = EpiPlain{(bf16_t*)(ws + OFF_EB), 1536, 0}; vA = pB + (size_t)1536 * 1024; vM = 512; }
                break;
            case OP_GEMM_QB:
                jp = true; pA = (const bf16_t*)(ws + OFF_EB) + 1024; pldA = 1536; pK = 256; pB = (const bf16_t*)(ws + OFF_QB) + li * SZ_QB; pN = 768; eP = EpiPlain{(bf16_t*)(ws + OFF_QD), 768, 0};
                break;
            case OP_GEMM_KVB:
                jp = jv = true; pA = (const bf16_t*)(ws + OFF_EB) + 1280; pldA = 1536; pK = 128; pB = (const bf16_t*)(ws + OFF_KVB) + li * SZ_KVB; pN = 512; eP = EpiPlain{(bf16_t*)(ws + OFF_KD), 768, 1};
                vA = pB + (size_t)512 * 128; vM = 512; vB = pA; vldB = 1536; vK = 128; vhead = 8;
                break;
            case OP_GEMM_OUT:
                jr = true; rA = (const bf16_t*)(ws + OFF_HM); rK = 1024; rB = (const bf16_t*)(ws + (even ? OFF_EVOUT : OFF_ODOUT)) + li * SZ_OUT; rxin = xin;
                break;
            case OP_GEMM_GU: jg = true; break;
            default:
                jr = true; rA = (const bf16_t*)(ws + OFF_ACT); rK = DFF; rB = (const bf16_t*)(ws + OFF_DN) + layer * SZ_DN; rxin = p.out;
                break;
            }
            if (jp) run_gemm(smem, pA, pldA, M_TOK, pB, pK, pN, pK, eP);
            if (jv) run_gemm(smem, vA, vK, vM, vB, vldB, M_TOK, vK, EpiVT{(bf16_t*)(ws + OFF_VT), vhead});
            if (jr) run_gemm(smem, rA, rK, M_TOK, rB, rK, 1024, rK, EpiResid{rxin, p.out});
            for (int rep = 0; rep < DBG_REP_GU; ++rep)
            if (jg) run_gemm(smem, (const bf16_t*)(ws + OFF_HM), 1024, M_TOK, (const bf16_t*)(ws + OFF_GU) + layer * SZ_GU, 1024, 5632, 1024, EpiSwiglu{(bf16_t*)(ws + OFF_ACT)});
            if (sync) gsync(bar, btarget);
            if (DBG_EXTRA_SYNC) gsync(bar, btarget);
        }
    }
#ifdef DBG_STEPS
    gsync(bar, btarget);
    {
        const size_t n = (size_t)M_TOK * 1024;
        const bf16_t* b0 = (const bf16_t*)(ws + OFF_HM);
        const bf16_t* b1 = (const bf16_t*)(ws + DBG_OFF1);
        const bf16_t* b2 = (const bf16_t*)(ws + DBG_OFF2);
        const bf16_t* b3 = (const bf16_t*)(ws + OFF_EB + (size_t)M_TOK * 1024 * 2);
        for (size_t i = (size_t)blockIdx.x * NT + threadIdx.x; i < n; i += (size_t)gridDim.x * NT) {
            float v = bf_lo(b0[i]) + bf_lo(b1[i]) + bf_lo(b2[i]) + bf_lo(b3[i]);
            if (DBG_STEPS >= 5) v += p.out[i];
            p.out[i] = v;
        }
    }
#endif
}

extern "C" void kernel_launch(void* const* d_in, const int* in_sizes, int n_in, void* d_out, int out_size, void* d_ws, size_t ws_size,
                              hipStream_t stream) {
    if (ws_size < OFF_END + 256) return;
    static int grid_blocks = 0;
    if (!grid_blocks) {
        int dev = 0, cus = 0, per_cu = 0;
        hipGetDevice(&dev);
        hipDeviceGetAttribute(&cus, hipDeviceAttributeMultiprocessorCount, dev);
        hipFuncSetAttribute((const void*)fwd_megakernel, hipFuncAttributeMaxDynamicSharedMemorySize, SMEM_BYTES);
        hipOccupancyMaxActiveBlocksPerMultiprocessor(&per_cu, fwd_megakernel, NT, SMEM_BYTES);
        if (per_cu > 1) per_cu = 1;
        if (per_cu < 1) per_cu = 1;
        grid_blocks = cus * per_cu;
    }
    Params p{};
    p.x = (const float*)d_in[0]; p.ffn_norm = (const float*)d_in[1]; p.w_gu = (const float*)d_in[2]; p.w_dn = (const float*)d_in[3];
    p.rel_bias = (const float*)d_in[4]; p.ev_norm = (const float*)d_in[5]; p.ev_w_in = (const float*)d_in[6]; p.ev_fb = (const float*)d_in[7];
    p.ev_qn = (const float*)d_in[8]; p.ev_kn = (const float*)d_in[9]; p.ev_w_out = (const float*)d_in[10]; p.od_norm = (const float*)d_in[11];
    p.od_w_in = (const float*)d_in[12]; p.od_mqn = (const float*)d_in[13]; p.od_mkn = (const float*)d_in[14]; p.od_qan = (const float*)d_in[15];
    p.od_wqb = (const float*)d_in[16]; p.od_kvan = (const float*)d_in[17]; p.od_wkvb = (const float*)d_in[18]; p.od_lqn = (const float*)d_in[19];
    p.od_lkn = (const float*)d_in[20]; p.od_w_out = (const float*)d_in[21];
    p.out = (float*)d_out; p.ws = (char*)d_ws;
    hipMemsetAsync((char*)d_ws + OFF_BAR, 0, 256, stream);
    void* args[] = {&p};
    hipError_t e = hipLaunchCooperativeKernel((void*)fwd_megakernel, dim3(grid_blocks), dim3(NT), args, SMEM_BYTES, stream);
    if (e != hipSuccess) fprintf(stderr, "cooperative launch failed: %s (grid %d)\n", hipGetErrorString(e), grid_blocks);
}
```

```cpp
#include <hip/hip_runtime.h>
#include <hip/hip_cooperative_groups.h>
#include <cstdio>
#include <cstdint>
#include <type_traits>
namespace cg = cooperative_groups;

typedef unsigned short bf16_t;
typedef short bf16x8 __attribute__((ext_vector_type(8)));
typedef float f32x4 __attribute__((ext_vector_type(4)));
typedef unsigned u32x4 __attribute__((ext_vector_type(4)));
typedef unsigned u32x2 __attribute__((ext_vector_type(2)));

#define DEV __device__ __forceinline__
#define NO_SB_EXIT 0
#define DBG_REP_ATTN 1
#define DBG_REP_GU 1
#define DBG_REP_SMALL 1
#define DBG_EXTRA_SYNC 0
#define DBG_SKIP_SB 0
#define DBG_NOSHFL 0
#define DBG_SKIP_FOX 0
#define DBG_OFF1 OFF_EB
#define DBG_OFF2 OFF_VT

constexpr int M_TOK = 32768, SEQ = 4096, DM = 1024, DFF = 2816;
constexpr float EPS = 1e-6f;
constexpr float LOG2E = 1.4426950408889634f;

constexpr size_t SZ_EVIN = 3200ull * 1024, SZ_ODIN = 2048ull * 1024, SZ_OUT = 1024ull * 1024, SZ_GU = 5632ull * 1024,
                 SZ_DN = 1024ull * 2816, SZ_QB = 768ull * 256, SZ_KVB = 1024ull * 128;
constexpr size_t OFF_EVIN = 0;
constexpr size_t OFF_ODIN = OFF_EVIN + 2 * SZ_EVIN * 2;
constexpr size_t OFF_EVOUT = OFF_ODIN + 2 * SZ_ODIN * 2;
constexpr size_t OFF_ODOUT = OFF_EVOUT + 2 * SZ_OUT * 2;
constexpr size_t OFF_GU = OFF_ODOUT + 2 * SZ_OUT * 2;
constexpr size_t OFF_DN = OFF_GU + 4 * SZ_GU * 2;
constexpr size_t OFF_QB = OFF_DN + 4 * SZ_DN * 2;
constexpr size_t OFF_KVB = OFF_QB + 2 * SZ_QB * 2;
constexpr size_t OFF_HM = OFF_KVB + 2 * SZ_KVB * 2;
constexpr size_t OFF_EB = OFF_HM + (size_t)M_TOK * 1024 * 2;
constexpr size_t OFF_VT = OFF_EB + (size_t)M_TOK * 2048 * 2;
constexpr size_t OFF_QD = OFF_VT + (size_t)M_TOK * 1024 * 2;
constexpr size_t OFF_KD = OFF_QD + (size_t)M_TOK * 768 * 2;
constexpr size_t OFF_FA = OFF_KD + (size_t)M_TOK * 768 * 2;
constexpr size_t OFF_CDEC = OFF_FA + (size_t)M_TOK * 8 * 4;
constexpr size_t OFF_KMEAN = OFF_CDEC + 64ull * 4096 * 4;
constexpr size_t OFF_SEL = OFF_KMEAN + 8ull * 8 * 16 * 64 * 4;
constexpr size_t OFF_BTAB = OFF_SEL + 64ull * 4096 * 4;
constexpr size_t OFF_ROPE = OFF_BTAB + 8ull * 128 * 4;
constexpr size_t OFF_END = OFF_ROPE + 2ull * 4096 * 16 * 4;
constexpr size_t OFF_BAR = OFF_END;
constexpr size_t OFF_ACT = OFF_EB;
static_assert((size_t)M_TOK * DFF * 2 <= (size_t)M_TOK * 3072 * 2, "ACT overlay");

constexpr int SMEM_BYTES = 131072;
constexpr int NT = 512;

struct Params {
    const float* x; const float* ffn_norm; const float* w_gu; const float* w_dn; const float* rel_bias;
    const float* ev_norm; const float* ev_w_in; const float* ev_fb; const float* ev_qn; const float* ev_kn; const float* ev_w_out;
    const float* od_norm; const float* od_w_in; const float* od_mqn; const float* od_mkn; const float* od_qan; const float* od_wqb;
    const float* od_kvan; const float* od_wkvb; const float* od_lqn; const float* od_lkn; const float* od_w_out;
    float* out; char* ws;
};

typedef __bf16 bf16v2_t __attribute__((ext_vector_type(2)));
typedef float f32x2_t __attribute__((ext_vector_type(2)));
DEV unsigned pk_bf16(float lo, float hi) { f32x2_t v = {lo, hi}; bf16v2_t b = __builtin_convertvector(v, bf16v2_t); return __builtin_bit_cast(unsigned, b); }
DEV int opq_v(int x) { asm volatile("" : "+v"(x)); return x; }
DEV int opq_s(int x) { asm volatile("" : "+s"(x)); return x; }
#define TID opq_v((int)threadIdx.x)
#define BID opq_s((int)blockIdx.x)
DEV float bf_lo(unsigned u) { return __uint_as_float(u << 16); }
DEV float bf_hi(unsigned u) { return __uint_as_float(u & 0xffff0000u); }

enum { WM_ID = 0, WM_EVIN, WM_ODIN, WM_GU, WM_KVB };
DEV int srcmap(int mode, int n) {
    switch (mode) {
    case WM_EVIN:
        if (n < 1024) return n;
        if (n < 1536) return 1544 + (n - 1024);
        if (n < 2048) return 2056 + (n - 1536);
        if (n < 2560) return 1024 + (n - 2048);
        if (n < 3072) return 2568 + (n - 2560);
        return -1;
    case WM_ODIN:
        if (n < 1024) return n;
        if (n < 1280) return 1536 + (n - 1024);
        if (n < 1408) return 1792 + (n - 1280);
        if (n < 1440) return 1920 + (n - 1408);
        if (n < 1536) return -1;
        return 1024 + (n - 1536);
    case WM_GU: { const int pn = n >> 8, bj = (n >> 7) & 1, t = n & 127; return bj * 2816 + 128 * pn + t; }
    case WM_KVB: { if (n < 512) return (n >> 6) * 128 + (n & 63); int m = n - 512; return (m >> 6) * 128 + 64 + (m & 63); }
    default: return n;
    }
}

DEV void convert_matrix(const float* __restrict__ W, bf16_t* __restrict__ Bt, int K, int N, int Np, int mode, float* lds) {
    const int tid = TID;
    const int nkt = K >> 6, ntiles = (Np >> 6) * nkt;
    for (int t = BID; t < ntiles; t += gridDim.x) {
        const int k0 = (t % nkt) << 6, n0 = (t / nkt) << 6;
        const int nn = tid & 63, src = srcmap(mode, n0 + nn);
        __syncthreads();
#pragma unroll 4
        for (int i = 0; i < 8; ++i) {
            const int kk = (tid >> 6) + 8 * i;
            lds[nn * 65 + kk] = src >= 0 ? W[(size_t)(k0 + kk) * N + src] : 0.f;
        }
        __syncthreads();
        const int r = tid >> 3, c = tid & 7;
        const float* lp = lds + r * 65 + c * 8;
        u32x4 a;
        a.x = pk_bf16(lp[0], lp[1]); a.y = pk_bf16(lp[2], lp[3]); a.z = pk_bf16(lp[4], lp[5]); a.w = pk_bf16(lp[6], lp[7]);
        *(u32x4*)(Bt + (size_t)(n0 + r) * K + k0 + c * 8) = a;
    }
}

DEV void prologue(const Params& p, char* smem) {
    float* lds = (float*)smem;
    char* ws = p.ws;
    for (int i = 0; i < 2; ++i) {
        convert_matrix(p.ev_w_in + (size_t)i * 1024 * 3080, (bf16_t*)(ws + OFF_EVIN) + i * SZ_EVIN, 1024, 3080, 3072, WM_EVIN, lds);
        convert_matrix(p.od_w_in + (size_t)i * 1024 * 1952, (bf16_t*)(ws + OFF_ODIN) + i * SZ_ODIN, 1024, 1952, 2048, WM_ODIN, lds);
        convert_matrix(p.ev_w_out + (size_t)i * 1024 * 1024, (bf16_t*)(ws + OFF_EVOUT) + i * SZ_OUT, 1024, 1024, 1024, WM_ID, lds);
        convert_matrix(p.od_w_out + (size_t)i * 1024 * 1024, (bf16_t*)(ws + OFF_ODOUT) + i * SZ_OUT, 1024, 1024, 1024, WM_ID, lds);
        convert_matrix(p.od_wqb + (size_t)i * 256 * 768, (bf16_t*)(ws + OFF_QB) + i * SZ_QB, 256, 768, 768, WM_ID, lds);
        convert_matrix(p.od_wkvb + (size_t)i * 128 * 1024, (bf16_t*)(ws + OFF_KVB) + i * SZ_KVB, 128, 1024, 1024, WM_KVB, lds);
    }
    for (int l = 0; l < 4; ++l) {
        convert_matrix(p.w_gu + (size_t)l * 1024 * 5632, (bf16_t*)(ws + OFF_GU) + l * SZ_GU, 1024, 5632, 5632, WM_GU, lds);
        convert_matrix(p.w_dn + (size_t)l * 2816 * 1024, (bf16_t*)(ws + OFF_DN) + l * SZ_DN, 2816, 1024, 1024, WM_ID, lds);
    }
    const int gt = BID * blockDim.x + TID, gn = gridDim.x * blockDim.x;
    float* btab = (float*)(ws + OFF_BTAB);
    for (int i = gt; i < 8 * 128; i += gn) {
        const int h = i >> 7, n = i & 127;
        int bucket;
        if (n < 16) bucket = n;
        else { const float v = logf((float)n / 16.0f) / 2.0794415416798357f * 16.0f; bucket = 16 + (int)v; if (bucket > 31) bucket = 31; }
        btab[i] = p.rel_bias[h * 32 + bucket] * LOG2E;
    }
    float* rope = (float*)(ws + OFF_ROPE);
    for (int i = gt; i < 4096 * 16; i += gn) {
        const int pos = i >> 4, f = i & 15;
        const float inv = powf(10000.0f, -(float)f / 16.0f);
        const float ang = (float)pos * inv;
        const double a = (double)ang;
        const double r = a - 6.283185307179586476925 * rint(a * 0.15915494309189533577);
        const float fr_ = (float)(r * 0.15915494309189533577);
        rope[i] = __builtin_amdgcn_cosf(fr_);
        rope[4096 * 16 + i] = __builtin_amdgcn_sinf(fr_);
    }
}

DEV void norm_phase(const float* __restrict__ x, const float* __restrict__ gain, bf16_t* __restrict__ h, const float* __restrict__ wfa, float* __restrict__ FA, char* smem) {
    const int tid = TID, lane = tid & 63, wv = (BID * NT + tid) >> 6, nw = (gridDim.x * NT) >> 6;
    float* wl = (float*)smem;
    if (wfa) {
        __syncthreads();
        for (int i = tid; i < 8192; i += NT) { const int k = i >> 3, j = i & 7; wl[j * 1024 + k] = wfa[(size_t)k * 3080 + 1536 + j]; }
        __syncthreads();
    }
    f32x4 g[4];
#pragma unroll
    for (int i = 0; i < 4; ++i) g[i] = *(const f32x4*)(gain + 4 * (lane + 64 * i));
    for (int row = wv; row < M_TOK; row += nw) {
        const float* xr = x + (size_t)row * DM;
        f32x4 v[4]; float ss = 0.f;
#pragma unroll
        for (int i = 0; i < 4; ++i) { v[i] = *(const f32x4*)(xr + 4 * (lane + 64 * i)); ss += v[i][0] * v[i][0] + v[i][1] * v[i][1] + v[i][2] * v[i][2] + v[i][3] * v[i][3]; }
#pragma unroll
        for (int o = 32; o > 0; o >>= 1) ss += __shfl_xor(ss, o);
        const float rstd = rsqrtf(ss * (1.0f / DM) + EPS);
        bf16_t* hr = h + (size_t)row * DM;
#pragma unroll
        for (int i = 0; i < 4; ++i) {
            v[i] = v[i] * rstd * g[i];
            u32x2 o; o.x = pk_bf16(v[i][0], v[i][1]); o.y = pk_bf16(v[i][2], v[i][3]);
            *(u32x2*)(hr + 4 * (lane + 64 * i)) = o;
        }
        if (wfa) {
            float fs[8];
#pragma unroll
            for (int j = 0; j < 8; ++j) {
                float a = 0.f;
#pragma unroll
                for (int i = 0; i < 4; ++i) { const f32x4 w = *(const f32x4*)(wl + j * 1024 + 4 * (lane + 64 * i)); a += v[i][0] * w[0] + v[i][1] * w[1] + v[i][2] * w[2] + v[i][3] * w[3]; }
#pragma unroll
                for (int o = 32; o > 0; o >>= 1) a += __shfl_xor(a, o);
                fs[j] = a;
            }
            if (lane == 0) { *(f32x4*)(FA + (size_t)row * 8) = (f32x4){fs[0], fs[1], fs[2], fs[3]}; *(f32x4*)(FA + (size_t)row * 8 + 4) = (f32x4){fs[4], fs[5], fs[6], fs[7]}; }
        }
    }
}

namespace pg8 {
#define PG8_LAS __attribute__((address_space(3)))
constexpr int BM = 256, BK = 64, HALF = 128, HTB = HALF * BK * 2, STAGE_BYTES = 8 * HTB, NXCD = 8, WGM = 8;
DEV int lds_byte(int r, int c) { const int st = (r >> 4) * 2 + (c >> 5), rr = r & 15, cc = c & 31, ob = rr * 64 + cc * 2; return st * 1024 + (ob ^ (((ob >> 9) & 1) << 5)); }
DEV void stage_rc(int b, int& R, int& C) { const int st = b / 1024, sb = b % 1024, swz = sb ^ (((sb >> 9) & 1) << 5); R = (st >> 1) * 16 + swz / 64; C = (st & 1) * 32 + (swz % 64) / 2; }
DEV int perm32(int rho) { const int n = rho >> 4, i = rho & 15; return 8 * (i >> 2) + 4 * n + (i & 3); }
struct Unit { int pm, pn; };
struct Gemm { const bf16_t* A; const bf16_t* Bt; int M, N, K, ldA, ldB; };
struct StaticOrder {
    int nM, nN, nwg, G, c;
    DEV void init(int M, int N, int G_, int c_) { nM = M / BM; nN = N / BM; nwg = nM * nN; G = G_; c = c_; }
    DEV bool next(int i, Unit& u) const {
        const long L = (long)i * G + c; if (L >= nwg) return false;
        int wgid = (int)L; { const int q = nwg / NXCD, r = nwg % NXCD, xcd = wgid % NXCD, off = wgid / NXCD; wgid = (xcd < r ? xcd * (q + 1) : r * (q + 1) + (xcd - r) * q) + off; }
        const int nig = WGM * nN, gid = wgid / nig, fm = gid * WGM, gsz = (nM - fm) < WGM ? (nM - fm) : WGM;
        u.pm = fm + ((wgid % nig) % gsz); u.pn = (wgid % nig) / gsz; return true;
    }
};
template <class Epi>
DEV void gemm_phase(PG8_LAS unsigned char* lds, const Gemm g, const StaticOrder& S, const Epi& E) {
    const int tid = TID, wid = __builtin_amdgcn_readfirstlane(tid >> 6), lane = tid & 63, wr = wid >> 2, wc = wid & 3, fr = lane & 15, fq = lane >> 4;
    const int K = g.K, nt = K / BK;
    unsigned voffA[2], voffB[2];
#pragma unroll
    for (int i = 0; i < 2; ++i) { int R, C; stage_rc(tid * 16 + i * 8192, R, C); const int Rb = (R & ~31) + perm32(R & 31);
        voffA[i] = (unsigned)(R * g.ldA + C) * 2u; voffB[i] = (unsigned)(Rb * g.ldB + C) * 2u; }
    const size_t kstep = (size_t)(BK * 2);
    const size_t hstepA = (size_t)HALF * g.ldA * 2, hstepB = (size_t)HALF * g.ldB * 2, tstepA = 2 * hstepA, tstepB = 2 * hstepB;
    const unsigned ldsw = (unsigned)wid * 1024u;
    const int aoff = lds_byte(wr * 64 + fr, fq * 8), boff = lds_byte(wc * 32 + fr, fq * 8);
#define PG8_SA(b, h) (((b) * 2 + (h)) * HTB)
#define PG8_SB(b, h) ((4 + (b) * 2 + (h)) * HTB)
#define PG8_STAGE(bufoff, gbase, voff) do { _Pragma("unroll") for (int _i = 0; _i < 2; ++_i) \
        __builtin_amdgcn_global_load_lds((const unsigned*)((const char*)(gbase) + (voff)[_i]), (PG8_LAS unsigned*)(lds + (bufoff) + ldsw + _i * 8192), 16, 0, 0); } while (0)
#define PG8_LDA(dst, b, h) do { _Pragma("unroll") for (int m = 0; m < 4; ++m) _Pragma("unroll") for (int k = 0; k < 2; ++k) dst[m][k] = *(const PG8_LAS bf16x8*)(lds + PG8_SA(b, h) + aoff + m * 2048 + k * 1024); } while (0)
#define PG8_LDB(dst, b, h) do { _Pragma("unroll") for (int n = 0; n < 2; ++n) _Pragma("unroll") for (int k = 0; k < 2; ++k) dst[n][k] = *(const PG8_LAS bf16x8*)(lds + PG8_SB(b, h) + boff + n * 2048 + k * 1024); } while (0)
#define PG8_MMA(ai, bj, At, Bt) do { __builtin_amdgcn_s_setprio(1); _Pragma("unroll") for (int m = 0; m < 4; ++m) _Pragma("unroll") for (int n = 0; n < 2; ++n) _Pragma("unroll") for (int k = 0; k < 2; ++k) \
        acc[ai][bj][m][n] = __builtin_amdgcn_mfma_f32_16x16x32_bf16(Bt[n][k], At[m][k], acc[ai][bj][m][n], 0, 0, 0); __builtin_amdgcn_s_setprio(0); } while (0)
#define PG8_WAIT_V(n) asm volatile("s_waitcnt vmcnt(" #n ")" ::: "memory")
#define PG8_WAIT_L(n) asm volatile("s_waitcnt lgkmcnt(" #n ")" ::: "memory")
#define PG8_BAR __builtin_amdgcn_s_barrier()
#define PG8_SCHED __builtin_amdgcn_sched_barrier(0)
    Unit cur, nxt; int ui = 0;
    if (!S.next(0, cur)) return;
    f32x4 acc[2][2][4][2];
#pragma unroll
    for (int a = 0; a < 2; ++a)
#pragma unroll
        for (int b = 0; b < 2; ++b)
#pragma unroll
            for (int m = 0; m < 4; ++m)
#pragma unroll
                for (int n = 0; n < 2; ++n) acc[a][b][m][n] = (f32x4){0.f, 0.f, 0.f, 0.f};
    bf16x8 At[4][2], B0[2][2], B1[2][2];
    const char* cA = (const char*)g.A + (size_t)cur.pm * tstepA; const char* cB = (const char*)g.Bt + (size_t)cur.pn * tstepB;
    PG8_STAGE(PG8_SB(0, 0), cB, voffB); PG8_STAGE(PG8_SB(0, 1), cB + hstepB, voffB); PG8_STAGE(PG8_SA(0, 0), cA, voffA); PG8_STAGE(PG8_SA(0, 1), cA + hstepA, voffA);
    if (wr == 1) PG8_BAR;
    PG8_WAIT_V(2); PG8_BAR;
    PG8_STAGE(PG8_SB(1, 0), cB + kstep, voffB); PG8_STAGE(PG8_SA(1, 0), cA + kstep, voffA); PG8_STAGE(PG8_SB(1, 1), cB + hstepB + kstep, voffB);
    PG8_WAIT_V(6); PG8_BAR;
    for (;;) {
        const bool has_next = S.next(ui + 1, nxt);
        const char* nA = has_next ? (const char*)g.A + (size_t)nxt.pm * tstepA : cA; const char* nB = has_next ? (const char*)g.Bt + (size_t)nxt.pn * tstepB : cB;
        for (int t = 0; t < nt; t += 2) {
            const bool last = (t == nt - 2);
            const char* a1 = cA + (size_t)(t + 1) * kstep;
            const char* a2 = last ? nA : cA + (size_t)(t + 2) * kstep; const char* b2 = last ? nB : cB + (size_t)(t + 2) * kstep;
            const char* a3 = a2 + kstep; const char* b3 = b2 + kstep;
            PG8_LDB(B0, 0, 0); PG8_LDB(B1, 0, 1); PG8_SCHED; PG8_LDA(At, 0, 0); PG8_STAGE(PG8_SA(1, 1), a1 + hstepA, voffA);
            PG8_WAIT_V(8); PG8_WAIT_L(0); PG8_BAR; PG8_MMA(0, 0, At, B0); PG8_MMA(0, 1, At, B1); PG8_BAR; PG8_SCHED;
            PG8_LDA(At, 0, 1); PG8_STAGE(PG8_SB(0, 0), b2, voffB); PG8_STAGE(PG8_SB(0, 1), b2 + hstepB, voffB); PG8_STAGE(PG8_SA(0, 0), a2, voffA);
            PG8_WAIT_V(8); PG8_WAIT_L(0); PG8_BAR; PG8_MMA(1, 0, At, B0); PG8_MMA(1, 1, At, B1); PG8_BAR; PG8_SCHED;
            PG8_LDB(B0, 1, 0); PG8_LDB(B1, 1, 1); PG8_SCHED; PG8_LDA(At, 1, 0); PG8_STAGE(PG8_SA(0, 1), a2 + hstepA, voffA);
            PG8_WAIT_V(8); PG8_WAIT_L(0); PG8_BAR; PG8_MMA(0, 0, At, B0); PG8_MMA(0, 1, At, B1); PG8_BAR; PG8_SCHED;
            PG8_LDA(At, 1, 1); PG8_STAGE(PG8_SB(1, 0), b3, voffB); PG8_STAGE(PG8_SB(1, 1), b3 + hstepB, voffB); PG8_STAGE(PG8_SA(1, 0), a3, voffA);
            PG8_WAIT_V(8); PG8_WAIT_L(0); PG8_BAR; PG8_MMA(1, 0, At, B0); PG8_MMA(1, 1, At, B1); PG8_BAR; PG8_SCHED;
        }
        if (wr == 0) PG8_BAR;
        E(acc, cur, wr, wc, fr, fq);
        if (!has_next) break;
#pragma unroll
        for (int a = 0; a < 2; ++a)
#pragma unroll
            for (int b = 0; b < 2; ++b)
#pragma unroll
                for (int m = 0; m < 4; ++m)
#pragma unroll
                    for (int n = 0; n < 2; ++n) acc[a][b][m][n] = (f32x4){0.f, 0.f, 0.f, 0.f};
        cur = nxt; cA = nA; cB = nB; ++ui;
        if (wr == 1) PG8_BAR;
    }
    PG8_WAIT_V(0);
    PG8_BAR;
#undef PG8_SA
#undef PG8_SB
#undef PG8_STAGE
#undef PG8_LDA
#undef PG8_LDB
#undef PG8_MMA
#undef PG8_WAIT_V
#undef PG8_WAIT_L
#undef PG8_BAR
#undef PG8_SCHED
}
}

typedef f32x4 AccT[2][2][4][2];
DEV u32x4 pack8(const f32x4& a, const f32x4& b) { u32x4 w; w.x = pk_bf16(a[0], a[1]); w.y = pk_bf16(a[2], a[3]); w.z = pk_bf16(b[0], b[1]); w.w = pk_bf16(b[2], b[3]); return w; }

struct EpiPlain {
    bf16_t* C; int ldc; int kd;
    DEV void operator()(const AccT& acc, const pg8::Unit& u, int wr, int wc, int fr, int fq) const {
        const int row0 = u.pm * 256 + wr * 64 + fr, col0 = u.pn * 256 + wc * 32 + 8 * fq;
#pragma unroll
        for (int ai = 0; ai < 2; ++ai)
#pragma unroll
            for (int m = 0; m < 4; ++m) {
                bf16_t* rowp = C + (size_t)(row0 + ai * 128 + m * 16) * ldc;
#pragma unroll
                for (int bj = 0; bj < 2; ++bj) { int col = col0 + bj * 128; if (kd) col = (col >> 6) * 96 + (col & 63);
                    *(u32x4*)(rowp + col) = pack8(acc[ai][bj][m][0], acc[ai][bj][m][1]); }
            }
    }
};
struct EpiResid {
    const float* xin; float* xout;
    DEV void operator()(const AccT& acc, const pg8::Unit& u, int wr, int wc, int fr, int fq) const {
        const int row0 = u.pm * 256 + wr * 64 + fr, col0 = u.pn * 256 + wc * 32 + 8 * fq;
#pragma unroll
        for (int ai = 0; ai < 2; ++ai)
#pragma unroll
            for (int m = 0; m < 4; ++m) {
                const size_t ro = (size_t)(row0 + ai * 128 + m * 16) * DM;
#pragma unroll
                for (int bj = 0; bj < 2; ++bj) { const size_t o = ro + col0 + bj * 128;
                    const f32x4 x0 = *(const f32x4*)(xin + o), x1 = *(const f32x4*)(xin + o + 4);
                    *(f32x4*)(xout + o) = x0 + acc[ai][bj][m][0]; *(f32x4*)(xout + o + 4) = x1 + acc[ai][bj][m][1]; }
            }
    }
};
struct EpiSwiglu {
    bf16_t* ACT;
    DEV void operator()(const AccT& acc, const pg8::Unit& u, int wr, int wc, int fr, int fq) const {
        const int row0 = u.pm * 256 + wr * 64 + fr, col0 = u.pn * 128 + wc * 32 + 8 * fq;
#pragma unroll
        for (int ai = 0; ai < 2; ++ai)
#pragma unroll
            for (int m = 0; m < 4; ++m) {
                f32x4 o[2];
#pragma unroll
                for (int n = 0; n < 2; ++n)
#pragma unroll
                    for (int j = 0; j < 4; ++j) { const float gv = acc[ai][0][m][n][j], uv = acc[ai][1][m][n][j]; o[n][j] = gv / (1.0f + __expf(-gv)) * uv; }
                *(u32x4*)(ACT + (size_t)(row0 + ai * 128 + m * 16) * DFF + col0) = pack8(o[0], o[1]);
            }
    }
};
struct EpiVT {
    bf16_t* VT; int head_base;
    DEV void operator()(const AccT& acc, const pg8::Unit& u, int wr, int wc, int fr, int fq) const {
        const int r0 = u.pm * 256 + wr * 64 + fr, c0 = u.pn * 256 + wc * 32 + 8 * fq;
#pragma unroll
        for (int ai = 0; ai < 2; ++ai)
#pragma unroll
            for (int m = 0; m < 4; ++m) {
                const int r = r0 + ai * 128 + m * 16, head = head_base + (r >> 6), d = r & 63;
#pragma unroll
                for (int bj = 0; bj < 2; ++bj) { const int c = c0 + bj * 128, b = c >> 12, sq = c & 4095;
                    *(u32x4*)(VT + ((size_t)((b * 16 + head) * 64 + d)) * 4096 + sq) = pack8(acc[ai][bj][m][0], acc[ai][bj][m][1]); }
            }
    }
};
template <class Epi>
DEV void run_gemm(char* smem, const bf16_t* A, int ldA, int M, const bf16_t* Bt, int ldB, int N, int K, const Epi& E) {
    __syncthreads();
    pg8::Gemm g{A, Bt, M, N, K, ldA, ldB}; pg8::StaticOrder S; S.init(M, N, (int)gridDim.x, BID);
    pg8::gemm_phase<Epi>((PG8_LAS unsigned char*)smem, g, S, E);
    __syncthreads();
}

template <int LPR, bool MEAN>
DEV void rownorm_block(bf16_t* buf, int ld, int col0, const float* __restrict__ gain, int row0, float* kmean_out, float* red) {
    constexpr int RPI = NT / LPR;
    const int tid = TID, sub = tid % LPR, rr = tid / LPR;
    float g[8], am[8];
#pragma unroll
    for (int i = 0; i < 8; ++i) { g[i] = gain[sub * 8 + i]; am[i] = 0.f; }
    for (int it = 0; it < 256 / RPI; ++it) {
        bf16_t* rp = buf + (size_t)(row0 + it * RPI + rr) * ld + col0 + sub * 8;
        const u32x4 v = *(const u32x4*)rp;
        float x[8] = {bf_lo(v.x), bf_hi(v.x), bf_lo(v.y), bf_hi(v.y), bf_lo(v.z), bf_hi(v.z), bf_lo(v.w), bf_hi(v.w)};
        float ss = 0.f;
#pragma unroll
        for (int i = 0; i < 8; ++i) ss += x[i] * x[i];
#pragma unroll
        for (int o = 1; o < LPR; o <<= 1) ss += __shfl_xor(ss, o);
        const float rstd = rsqrtf(ss * (1.0f / (LPR * 8)) + EPS);
#pragma unroll
        for (int i = 0; i < 8; ++i) { x[i] = x[i] * rstd * g[i]; if (MEAN) am[i] += x[i]; }
        u32x4 o; o.x = pk_bf16(x[0], x[1]); o.y = pk_bf16(x[2], x[3]); o.z = pk_bf16(x[4], x[5]); o.w = pk_bf16(x[6], x[7]);
        *(u32x4*)rp = o;
    }
    if (MEAN) {
        __syncthreads();
#pragma unroll
        for (int i = 0; i < 8; ++i) red[rr * 64 + sub * 8 + i] = am[i];
        __syncthreads();
        if (tid < 64) {
            float s = 0.f;
            for (int r = 0; r < RPI; ++r) s += red[r * 64 + tid];
            kmean_out[tid] = s * (1.0f / 256.0f);
        }
    }
}

DEV void even_post(const Params& p, int li, char* smem) {
    char* ws = p.ws;
    bf16_t* EB = (bf16_t*)(ws + OFF_EB);
    float* red = (float*)smem;
    for (int it = BID; it < 2048 + 64; it += gridDim.x) {
        if (it < 2048) {
            const int blk = it >> 4, hh = it & 15;
            rownorm_block<8, false>(EB, 2048, hh * 64, (hh < 8 ? p.ev_qn : p.ev_kn) + li * 64, blk * 256, nullptr, red);
        } else {
            const int bh = it - 2048, b = bh >> 3, h = bh & 7, tid = TID, lane = tid & 63, wid = tid >> 6;
            const float* FA = (const float*)(ws + OFF_FA);
            float* CD = (float*)(ws + OFF_CDEC) + (size_t)bh * 4096;
            const float fb = p.ev_fb[li * 8 + h];
            float lf[8]; float run = 0.f;
#pragma unroll
            for (int i = 0; i < 8; ++i) {
                const float z = FA[(size_t)(b * 4096 + tid * 8 + i) * 8 + h] + fb;
                const float ls = fminf(z, 0.f) - log1pf(expf(-fabsf(z)));
                run += ls; lf[i] = run;
            }
            float inc = run;
#pragma unroll
            for (int o = 1; o < 64; o <<= 1) { const float y = __shfl_up(inc, o); if (lane >= o) inc += y; }
            __syncthreads();
            if (lane == 63) red[wid] = inc;
            __syncthreads();
            float base = inc - run;
            for (int w = 0; w < wid; ++w) base += red[w];
#pragma unroll
            for (int i = 0; i < 8; ++i) CD[tid * 8 + i] = (base + lf[i]) * LOG2E;
            __syncthreads();
        }
    }
}

DEV void odd_post1(const Params& p, int li, char* smem) {
    char* ws = p.ws;
    bf16_t* OB = (bf16_t*)(ws + OFF_EB);
    float* red = (float*)smem;
    float* KM = (float*)(ws + OFF_KMEAN);
    for (int it = BID; it < 2304; it += gridDim.x) {
        if (it < 1024) {
            const int blk = it >> 3, h = it & 7, b = blk >> 4, nb = blk & 15;
            rownorm_block<8, true>(OB, 1536, 512 + h * 64, p.od_mkn + li * 64, blk * 256, KM + (size_t)((b * 8 + h) * 16 + nb) * 64, red);
            __syncthreads();
        } else if (it < 2048) {
            const int j = it - 1024, blk = j >> 3, h = j & 7;
            rownorm_block<8, false>(OB, 1536, h * 64, p.od_mqn + li * 64, blk * 256, nullptr, red);
        } else if (it < 2176) {
            rownorm_block<32, false>(OB, 1536, 1024, p.od_qan + li * 256, (it - 2048) * 256, nullptr, red);
        } else {
            rownorm_block<16, false>(OB, 1536, 1280, p.od_kvan + li * 128, (it - 2176) * 256, nullptr, red);
        }
    }
}

DEV void moba_gate(const Params& p) {
    char* ws = p.ws;
    const bf16_t* OB = (const bf16_t*)(ws + OFF_EB);
    const float* KM = (const float*)(ws + OFF_KMEAN);
    int* SEL = (int*)(ws + OFF_SEL);
    const int gt = BID * blockDim.x + TID, gn = gridDim.x * blockDim.x;
    for (int w = gt; w < 8 * M_TOK; w += gn) {
        const int h = w >> 15, token = w & (M_TOK - 1), b = token >> 12, s = token & 4095, cur = s >> 8;
        float q[64];
        const u32x4* qp = (const u32x4*)(OB + (size_t)token * 1536 + h * 64);
#pragma unroll
        for (int i = 0; i < 8; ++i) { const u32x4 v = qp[i]; q[8 * i] = bf_lo(v.x); q[8 * i + 1] = bf_hi(v.x); q[8 * i + 2] = bf_lo(v.y); q[8 * i + 3] = bf_hi(v.y);
            q[8 * i + 4] = bf_lo(v.z); q[8 * i + 5] = bf_hi(v.z); q[8 * i + 6] = bf_lo(v.w); q[8 * i + 7] = bf_hi(v.w); }
        float v1 = -INFINITY, v2 = -INFINITY, v3 = -INFINITY; int i1 = -1, i2 = -1, i3 = -1;
        const float* kmb = KM + (size_t)((b * 8 + h) * 16) * 64;
        for (int n = 0; n < cur; ++n) {
            const f32x4* km = (const f32x4*)(kmb + n * 64);
            float d = 0.f;
#pragma unroll
            for (int i = 0; i < 16; ++i) { const f32x4 k4 = km[i]; d += q[4 * i] * k4[0] + q[4 * i + 1] * k4[1] + q[4 * i + 2] * k4[2] + q[4 * i + 3] * k4[3]; }
            if (d > v1) { v3 = v2; i3 = i2; v2 = v1; i2 = i1; v1 = d; i1 = n; }
            else if (d > v2) { v3 = v2; i3 = i2; v2 = d; i2 = n; }
            else if (d > v3) { v3 = d; i3 = n; }
        }
        int m = 0;
        if (i1 >= 0) m |= 1 << i1;
        if (i2 >= 0) m |= 1 << i2;
        if (i3 >= 0) m |= 1 << i3;
        SEL[(size_t)(b * 8 + h) * 4096 + s] = m;
    }
}

DEV void mla_post(const Params& p, int li) {
    char* ws = p.ws;
    bf16_t* QD = (bf16_t*)(ws + OFF_QD);
    bf16_t* KD = (bf16_t*)(ws + OFF_KD);
    const bf16_t* OB = (const bf16_t*)(ws + OFF_EB);
    const float* rope = (const float*)(ws + OFF_ROPE);
    const int gt = BID * blockDim.x + TID, gn = gridDim.x * blockDim.x;
    for (int w = gt; w < 2 * 8 * M_TOK; w += gn) {
        const int isk = w >> 18, rem = w & ((1 << 18) - 1), token = rem >> 3, h = rem & 7, s = token & 4095;
        bf16_t* rp = (isk ? KD : QD) + (size_t)token * 768 + h * 96;
        const float* gain = (isk ? p.od_lkn : p.od_lqn) + li * 96;
        float x[96];
#pragma unroll
        for (int i = 0; i < 12; ++i) {
            u32x4 v;
            if (isk && i >= 8) v = *(const u32x4*)(OB + (size_t)token * 1536 + 1408 + (i - 8) * 8);
            else v = *(const u32x4*)(rp + i * 8);
            x[8 * i] = bf_lo(v.x); x[8 * i + 1] = bf_hi(v.x); x[8 * i + 2] = bf_lo(v.y); x[8 * i + 3] = bf_hi(v.y);
            x[8 * i + 4] = bf_lo(v.z); x[8 * i + 5] = bf_hi(v.z); x[8 * i + 6] = bf_lo(v.w); x[8 * i + 7] = bf_hi(v.w);
        }
        float ss = 0.f;
#pragma unroll
        for (int i = 0; i < 96; ++i) ss += x[i] * x[i];
        const float rstd = rsqrtf(ss * (1.0f / 96.0f) + EPS);
#pragma unroll
        for (int i = 0; i < 96; ++i) x[i] = x[i] * rstd * gain[i];
        const float* cs = rope + (size_t)s * 16;
        const float* sn = rope + 4096 * 16 + (size_t)s * 16;
#pragma unroll
        for (int i = 0; i < 16; ++i) {
            const float c = cs[i], sv = sn[i], a = x[64 + i], bb = x[80 + i];
            x[64 + i] = a * c - bb * sv; x[80 + i] = a * sv + bb * c;
        }
#pragma unroll
        for (int i = 0; i < 12; ++i) {
            u32x4 o; o.x = pk_bf16(x[8 * i], x[8 * i + 1]); o.y = pk_bf16(x[8 * i + 2], x[8 * i + 3]); o.z = pk_bf16(x[8 * i + 4], x[8 * i + 5]); o.w = pk_bf16(x[8 * i + 6], x[8 * i + 7]);
            *(u32x4*)(rp + i * 8) = o;
        }
    }
}

enum { AT_FOX = 0, AT_SB, AT_MOBA, AT_MLA };
constexpr int AT_KBUF = 13312, AT_VBUF = 8192, AT_K0 = 0, AT_V0 = 2 * AT_KBUF, AT_MISC = AT_V0 + 2 * AT_VBUF, AT_CK = AT_MISC + 1024;
constexpr int AT_QT = 16;

template <int MODE>
DEV void attn_item(const Params& p, char* smem, int b, int h, int qt, int li) {
    constexpr int DQK = (MODE == AT_MLA) ? 96 : 64;
    constexpr int NKS = DQK / 32;
    constexpr int KSTRB = (DQK + 8) * 2;
    constexpr int KCH = DQK / 8;
    constexpr int KLD = (64 * KCH + NT - 1) / NT;
    char* ws = p.ws;
    const int tid = TID, wid = tid >> 6, lane = tid & 63, fr = lane & 15, fq = lane >> 4;
    const bf16_t* Qb; const bf16_t* Kb; int ldq; int head16;
    if (MODE == AT_FOX) { Qb = (const bf16_t*)(ws + OFF_EB) + h * 64; Kb = Qb + 512; ldq = 2048; head16 = h; }
    else if (MODE == AT_SB) { Qb = (const bf16_t*)(ws + OFF_EB) + 1024 + h * 64; Kb = Qb + 512; ldq = 2048; head16 = 8 + h; }
    else if (MODE == AT_MOBA) { Qb = (const bf16_t*)(ws + OFF_EB) + h * 64; Kb = Qb + 512; ldq = 1536; head16 = h; }
    else { Qb = (const bf16_t*)(ws + OFF_QD) + h * 96; Kb = (const bf16_t*)(ws + OFF_KD) + h * 96; ldq = 768; head16 = 8 + h; }
    const bf16_t* Vt = (const bf16_t*)(ws + OFF_VT) + (size_t)((b * 16 + head16) * 64) * 4096;
    const size_t tokb = (size_t)b * 4096;
    const int qw0 = qt * 256 + wid * 32;
    int qpos[2] = {qw0 + fr, qw0 + 16 + fr};
    const int tlast = 4 * qt + 3;
    int* smi = (int*)(smem + AT_MISC);
    float* btab = (float*)(smem + AT_MISC + 512);

    __syncthreads();
    int mysel[2] = {0, 0};
    if (MODE == AT_MOBA) {
        const int* SEL = (const int*)(ws + OFF_SEL) + (size_t)(b * 8 + h) * 4096;
        mysel[0] = SEL[qpos[0]]; mysel[1] = SEL[qpos[1]];
        if (tid == 0) smi[73] = 0;
        if (tid < 128) btab[tid] = ((const float*)(ws + OFF_BTAB))[h * 128 + tid];
        __syncthreads();
        if (fq == 0) atomicOr(&smi[73], mysel[0] | mysel[1]);
        __syncthreads();
    }
    if (tid == 0) {
        int n = 0;
        if (MODE == AT_MLA) { for (int t = 0; t <= tlast; ++t) smi[n++] = t; }
        else if (MODE == AT_SB || MODE == AT_FOX) { for (int t = tlast; t >= 0; --t) smi[n++] = t; }
        else {
            const int um = smi[73];
            for (int t = qt * 4; t <= tlast; ++t) smi[n++] = t;
            for (int kb = 0; kb < qt; ++kb) if ((um >> kb) & 1) { for (int t = 0; t < 4; ++t) smi[n++] = kb * 4 + t; }
        }
        smi[72] = n;
    }
    __syncthreads();
    const int nt = smi[72];

    bf16x8 qf[2][NKS];
#pragma unroll
    for (int g = 0; g < 2; ++g) {
        const bf16_t* qp = Qb + (tokb + qpos[g]) * ldq + fq * 8;
#pragma unroll
        for (int ks = 0; ks < NKS; ++ks) qf[g][ks] = *(const bf16x8*)(qp + ks * 32);
    }
    float cq[2] = {0.f, 0.f};
    const float* CD = (const float*)(ws + OFF_CDEC) + (size_t)(b * 8 + h) * 4096;
    float sbound = 0.f;
    int wsel = 0;
    if (MODE == AT_FOX) {
        cq[0] = CD[qpos[0]]; cq[1] = CD[qpos[1]];
        float gq = fabsf(p.ev_qn[li * 64 + lane]), gk = fabsf(p.ev_kn[li * 64 + lane]);
#pragma unroll
        for (int o_ = 32; o_ > 0; o_ >>= 1) { gq = fmaxf(gq, __shfl_xor(gq, o_)); gk = fmaxf(gk, __shfl_xor(gk, o_)); }
        sbound = 8.0f * gq * gk * LOG2E * 1.02f;
    }
    if (MODE == AT_MOBA) {
        wsel = mysel[0] | mysel[1];
#pragma unroll
        for (int o_ = 32; o_ > 0; o_ >>= 1) wsel |= __shfl_xor(wsel, o_);
    }
    const float c1 = (MODE == AT_MLA ? 0.10206207261596577f : 0.125f) * (MODE == AT_SB ? 1.0f : LOG2E);
    const float bfar = (MODE == AT_MOBA) ? btab[127] : 0.f;

    f32x4 o[2][4];
#pragma unroll
    for (int g = 0; g < 2; ++g)
#pragma unroll
        for (int i = 0; i < 4; ++i) o[g][i] = (f32x4){0.f, 0.f, 0.f, 0.f};
    float mrun[2] = {-1e30f, -1e30f}, lsum[2] = {0.f, 0.f}, R[2] = {0.f, 0.f};

    u32x4 rk[KLD], rv; f32x4 rc = (f32x4){0.f, 0.f, 0.f, 0.f};
    auto gload = [&](int tile) {
        if (MODE == AT_FOX) { if (tid < 16) rc = *(const f32x4*)(CD + tile * 64 + tid * 4); }
#pragma unroll
        for (int i = 0; i < KLD; ++i) { const int idx = tid + NT * i, r = idx / KCH, c = idx % KCH; if (idx < 64 * KCH) rk[i] = *(const u32x4*)(Kb + (tokb + tile * 64 + r) * ldq + c * 8); }
        { const int d = tid >> 3, c8 = tid & 7; rv = *(const u32x4*)(Vt + (size_t)d * 4096 + tile * 64 + c8 * 8); }
    };
    auto lstore = [&](int buf) {
        char* kb = smem + AT_K0 + buf * AT_KBUF; char* vb = smem + AT_V0 + buf * AT_VBUF;
        if (MODE == AT_FOX) { if (tid < 16) *(f32x4*)(smem + AT_CK + buf * 256 + tid * 16) = rc; }
#pragma unroll
        for (int i = 0; i < KLD; ++i) { const int idx = tid + NT * i, r = idx / KCH, c = idx % KCH; if (idx < 64 * KCH) *(u32x4*)(kb + r * KSTRB + c * 16) = rk[i]; }
        { const int d = tid >> 3, c8 = tid & 7; *(u32x4*)(vb + ((c8 >> 1) * 64 + d) * 32 + (c8 & 1) * 16) = rv; }
    };
    gload(smi[0]); lstore(0);
    __syncthreads();
    for (int it = 0; it < nt; ++it) {
        const int tile = smi[it], buf = it & 1;
        const bool more = it + 1 < nt;
        if (more) gload(smi[it + 1]);
        const char* kb = smem + AT_K0 + buf * AT_KBUF; const char* vb = smem + AT_V0 + buf * AT_VBUF;
        const int kbase = tile * 64 + fq * 4;
        bool wave_live = (MODE == AT_SB) ? (tile * 64 < qw0 + 31) : (tile * 64 <= qw0 + 31);
        if (MODE == AT_MOBA) { if ((tile >> 2) != qt) wave_live = (wsel >> (tile >> 2)) & 1; }
        const bool diag = (tile * 64 + 63 >= qw0);
        float cnext = 0.f;
        if (MODE == AT_FOX) { if (tile > 0) cnext = CD[tile * 64 - 1]; }
        if (wave_live) {
        f32x4 s[2][4];
#pragma unroll
        for (int kt = 0; kt < 4; ++kt) {
            s[0][kt] = (f32x4){0.f, 0.f, 0.f, 0.f}; s[1][kt] = (f32x4){0.f, 0.f, 0.f, 0.f};
#pragma unroll
            for (int ks = 0; ks < NKS; ++ks) {
                const bf16x8 kf = *(const bf16x8*)(kb + (kt * 16 + fr) * KSTRB + (ks * 32 + fq * 8) * 2);
                s[0][kt] = __builtin_amdgcn_mfma_f32_16x16x32_bf16(kf, qf[0][ks], s[0][kt], 0, 0, 0);
                s[1][kt] = __builtin_amdgcn_mfma_f32_16x16x32_bf16(kf, qf[1][ks], s[1][kt], 0, 0, 0);
            }
        }
        const bool far_tile = (MODE == AT_MOBA) && (qt * 256 - (tile * 64 + 63) >= 127);
        unsigned pp[2][4][2];
        auto group = [&](auto GI) {
            constexpr int g = decltype(GI)::value;
            if (MODE == AT_SB) {
                float T[4], exq[4], ls[4][4], e[4][4];
#pragma unroll
                for (int kt = 0; kt < 4; ++kt) {
                    float v[4];
#pragma unroll
                    for (int j = 0; j < 4; ++j) {
                        const float z = s[g][kt][j] * c1;
                        const float sp = __logf(1.0f + __expf(-fabsf(z)));
                        const float l = fminf(z, 0.f) - sp;
                        const bool strict = !diag || (kbase + kt * 16 + j < qpos[g]);
                        ls[kt][j] = strict ? l : -INFINITY;
                        v[j] = strict ? (l - z) : 0.f;
                    }
                    e[kt][3] = 0.f; e[kt][2] = v[3]; e[kt][1] = v[3] + v[2]; e[kt][0] = e[kt][1] + v[1];
                    const float G = e[kt][0] + v[0];
                    float xs = G;
                    float y = __shfl_down(xs, 16); if (fq < 3) xs += y;
                    y = __shfl_down(xs, 32); if (fq < 2) xs += y;
                    exq[kt] = xs - G;
                    T[kt] = __shfl(xs, fr);
                }
                float off = R[g];
#pragma unroll
                for (int kt = 3; kt >= 0; --kt) {
                    float w[4];
#pragma unroll
                    for (int j = 0; j < 4; ++j) w[j] = __expf(ls[kt][j] + off + exq[kt] + e[kt][j]);
                    pp[g][kt][0] = pk_bf16(w[0], w[1]); pp[g][kt][1] = pk_bf16(w[2], w[3]);
                    off += T[kt];
                }
                R[g] = off;
            } else {
                float t[4][4];
                float mx = -1e30f;
                auto logits = [&](auto MASKED) {
                    constexpr bool MSK = decltype(MASKED)::value;
#pragma unroll
                    for (int kt = 0; kt < 4; ++kt) {
                        f32x4 bias = (f32x4){0.f, 0.f, 0.f, 0.f};
                        if (MODE == AT_FOX) { const f32x4 ck = *(const f32x4*)(smem + AT_CK + buf * 256 + (kt * 16 + fq * 4) * 4); bias = (f32x4){cq[g], cq[g], cq[g], cq[g]} - ck; }
                        bool blk_ok = true;
                        if (MODE == AT_MOBA) {
                            blk_ok = (tile >> 2) == qt || ((mysel[g] >> (tile >> 2)) & 1);
                            if (far_tile) { bias = (f32x4){bfar, bfar, bfar, bfar}; }
                            else {
#pragma unroll
                                for (int j = 0; j < 4; ++j) { int dist = qpos[g] - (kbase + kt * 16 + j); dist = dist < 0 ? 0 : (dist > 127 ? 127 : dist); bias[j] = btab[dist]; }
                            }
                        }
#pragma unroll
                        for (int j = 0; j < 4; ++j) {
                            float v = s[g][kt][j] * c1 + bias[j];
                            if (MSK) { const bool ok = blk_ok && (kbase + kt * 16 + j <= qpos[g]); v = ok ? v : -1e30f; }
                            else if (MODE == AT_MOBA) { v = blk_ok ? v : -1e30f; }
                            t[kt][j] = v; mx = fmaxf(mx, v);
                        }
                    }
                };
                if (diag) logits(std::true_type{}); else logits(std::false_type{});
                mx = fmaxf(mx, __shfl_xor(mx, 16)); mx = fmaxf(mx, __shfl_xor(mx, 32));
                const float mnew = fmaxf(mrun[g], mx);
                const float alpha = __builtin_amdgcn_exp2f(mrun[g] - mnew);
                mrun[g] = mnew;
                float ps = 0.f;
#pragma unroll
                for (int kt = 0; kt < 4; ++kt) {
                    float w[4];
#pragma unroll
                    for (int j = 0; j < 4; ++j) { w[j] = __builtin_amdgcn_exp2f(t[kt][j] - mnew); ps += w[j]; }
                    pp[g][kt][0] = pk_bf16(w[0], w[1]); pp[g][kt][1] = pk_bf16(w[2], w[3]);
                }
                lsum[g] = lsum[g] * alpha + ps;
#pragma unroll
                for (int i = 0; i < 4; ++i) o[g][i] = o[g][i] * alpha;
            }
        };
        group(std::integral_constant<int, 0>{});
        group(std::integral_constant<int, 1>{});
#pragma unroll
        for (int kk = 0; kk < 2; ++kk) {
            bf16x8 pf[2];
#pragma unroll
            for (int g = 0; g < 2; ++g) { u32x4 pw; pw.x = pp[g][2 * kk][0]; pw.y = pp[g][2 * kk][1]; pw.z = pp[g][2 * kk + 1][0]; pw.w = pp[g][2 * kk + 1][1]; pf[g] = __builtin_bit_cast(bf16x8, pw); }
#pragma unroll
            for (int dt = 0; dt < 4; ++dt) {
                const u32x2 lo = *(const u32x2*)(vb + ((2 * kk) * 64 + dt * 16 + fr) * 32 + fq * 8);
                const u32x2 hi = *(const u32x2*)(vb + ((2 * kk + 1) * 64 + dt * 16 + fr) * 32 + fq * 8);
                u32x4 vw; vw.x = lo.x; vw.y = lo.y; vw.z = hi.x; vw.w = hi.y;
                const bf16x8 vf = __builtin_bit_cast(bf16x8, vw);
                o[0][dt] = __builtin_amdgcn_mfma_f32_16x16x32_bf16(vf, pf[0], o[0][dt], 0, 0, 0);
                o[1][dt] = __builtin_amdgcn_mfma_f32_16x16x32_bf16(vf, pf[1], o[1][dt], 0, 0, 0);
            }
        }
        }
        if (more) lstore(buf ^ 1);
        if (MODE == AT_SB) {
            if (__syncthreads_and(R[0] < -40.0f && R[1] < -40.0f)) break;
        } else if (MODE == AT_FOX) {
            const float bnd = sbound - cnext;
            if (__syncthreads_and(tile == 0 || ((bnd + cq[0] < mrun[0] - 40.0f) && (bnd + cq[1] < mrun[1] - 40.0f)))) break;
        } else {
            __syncthreads();
        }
    }
#pragma unroll
    for (int g = 0; g < 2; ++g) {
        float inv = 1.0f;
        if (MODE != AT_SB) {
            float l = lsum[g]; l += __shfl_xor(l, 16); l += __shfl_xor(l, 32);
            inv = 1.0f / l;
        }
        bf16_t* op = (bf16_t*)(ws + OFF_HM) + (tokb + qpos[g]) * 1024 + head16 * 64 + fq * 4;
#pragma unroll
        for (int dt = 0; dt < 4; ++dt) {
            u32x2 w; w.x = pk_bf16(o[g][dt][0] * inv, o[g][dt][1] * inv); w.y = pk_bf16(o[g][dt][2] * inv, o[g][dt][3] * inv);
            *(u32x2*)(op + dt * 16) = w;
        }
    }
}

DEV void attn_phase(const Params& p, char* smem, bool even, unsigned* ctr, int li) {
    int* smi = (int*)(smem + AT_MISC);
    const int tid = TID;
    for (;;) {
        __syncthreads();
        if (tid == 0) smi[74] = (int)__hip_atomic_fetch_add(ctr, 1u, __ATOMIC_RELAXED, __HIP_MEMORY_SCOPE_AGENT);
        __syncthreads();
        const int it = smi[74];
        if (it >= AT_QT * 128) break;
        const int qt = AT_QT - 1 - (it >> 7), bh = it & 127, b = bh >> 4, h16 = bh & 15;
        if (even) { if (h16 < 8) attn_item<AT_FOX>(p, smem, b, h16, qt, li); else attn_item<AT_SB>(p, smem, b, h16 - 8, qt, li); }
        else { if (h16 < 8) attn_item<AT_MOBA>(p, smem, b, h16, qt, li); else attn_item<AT_MLA>(p, smem, b, h16 - 8, qt, li); }
    }
}

DEV void gsync(unsigned* ctr, unsigned& target) {
    asm volatile("s_waitcnt vmcnt(0) lgkmcnt(0)" ::: "memory");
    __syncthreads();
    target += gridDim.x;
    if (threadIdx.x == 0) {
        __builtin_amdgcn_fence(__ATOMIC_RELEASE, "agent");
        __hip_atomic_fetch_add(ctr, 1u, __ATOMIC_RELAXED, __HIP_MEMORY_SCOPE_AGENT);
        while (__hip_atomic_load(ctr, __ATOMIC_RELAXED, __HIP_MEMORY_SCOPE_AGENT) < target) __builtin_amdgcn_s_sleep(1);
        __builtin_amdgcn_fence(__ATOMIC_ACQUIRE, "agent");
    }
    __syncthreads();
}

enum { OP_NORM_MIX = 0, OP_GEMM_IN, OP_EPOST, OP_OPOST1, OP_GEMM_QB, OP_GEMM_KVB, OP_GATE, OP_MLAPOST, OP_ATTN, OP_GEMM_OUT, OP_NORM_FFN, OP_GEMM_GU, OP_GEMM_DN };

__global__ void __launch_bounds__(512) fwd_megakernel(Params p) {
    extern __shared__ __attribute__((aligned(16))) char smem[];
    cg::grid_group grid = cg::this_grid();
    char* ws = p.ws;
    unsigned* bar = (unsigned*)(ws + OFF_BAR);
    unsigned btarget = 0;
    grid.sync();
    for (int rep = 0; rep < DBG_REP_SMALL; ++rep) prologue(p, smem);
    gsync(bar, btarget);
    for (int gs = 0; gs < 40; ++gs) {
        {
            const int gq = opq_s(gs);
#ifdef DBG_STEPS
            if (gq >= DBG_STEPS) break;
#endif
            const int pair = gq / 20, rr20 = gq - pair * 20;
            const bool even = rr20 < 8;
            const int step = even ? rr20 : rr20 - 8;
            const int layer = pair * 2 + (even ? 0 : 1), li = pair;
            const float* xin = layer == 0 ? p.x : p.out;
            int op; bool sync = true;
            if (even) {
                switch (step) { case 0: op = OP_NORM_MIX; break; case 1: op = OP_GEMM_IN; break; case 2: op = OP_EPOST; break; case 3: op = OP_ATTN; break;
                                case 4: op = OP_GEMM_OUT; break; case 5: op = OP_NORM_FFN; break; case 6: op = OP_GEMM_GU; break; default: op = OP_GEMM_DN; break; }
            } else {
                switch (step) { case 0: op = OP_NORM_MIX; break; case 1: op = OP_GEMM_IN; break; case 2: op = OP_OPOST1; break; case 3: op = OP_GEMM_QB; break;
                                case 4: op = OP_GEMM_KVB; break; case 5: op = OP_GATE; break; case 6: op = OP_MLAPOST; break; case 7: op = OP_ATTN; break;
                                case 8: op = OP_GEMM_OUT; break; case 9: op = OP_NORM_FFN; break; case 10: op = OP_GEMM_GU; break; default: op = OP_GEMM_DN; break; }
            }
            if (op == OP_GEMM_QB || op == OP_GEMM_KVB) sync = false;
            bool jp = false, jv = false, jr = false, jg = false;
            const bf16_t *pA = nullptr, *pB = nullptr, *vA = nullptr, *vB = nullptr, *rA = nullptr, *rB = nullptr;
            int pldA = 0, pN = 0, pK = 0, vM = 0, vldB = 0, vK = 0, rK = 0, vhead = 0;
            EpiPlain eP{nullptr, 0, 0}; const float* rxin = nullptr;
            switch (op) {
            case OP_NORM_MIX: for (int rep = 0; rep < DBG_REP_SMALL; ++rep) norm_phase(xin, (even ? p.ev_norm : p.od_norm) + li * DM, (bf16_t*)(ws + OFF_HM), even ? p.ev_w_in + (size_t)li * 1024 * 3080 : nullptr, (float*)(ws + OFF_FA), smem); break;
            case OP_NORM_FFN: for (int rep = 0; rep < DBG_REP_SMALL; ++rep) norm_phase(p.out, p.ffn_norm + layer * DM, (bf16_t*)(ws + OFF_HM), nullptr, nullptr, smem); break;
            case OP_EPOST: even_post(p, li, smem); break;
            case OP_OPOST1: odd_post1(p, li, smem); break;
            case OP_GATE: for (int rep = 0; rep < DBG_REP_SMALL; ++rep) moba_gate(p); break;
            case OP_MLAPOST: mla_post(p, li); break;
            case OP_ATTN: attn_phase(p, smem, even, bar + 16 + layer, li); break;
            case OP_GEMM_IN:
                jp = jv = true; pA = (const bf16_t*)(ws + OFF_HM); pldA = 1024; pK = 1024; vB = pA; vldB = 1024; vK = 1024; vhead = 0;
                if (even) { pB = (const bf16_t*)(ws + OFF_EVIN) + li * SZ_EVIN; pN = 2048; eP = EpiPlain{(bf16_t*)(ws + OFF_EB), 2048, 0}; vA = pB + (size_t)2048 * 1024; vM = 1024; }
                else { pB = (const bf16_t*)(ws + OFF_ODIN) + li * SZ_ODIN; pN = 1536; eP = EpiPlain{(bf16_t*)(ws + OFF_EB), 1536, 0}; vA = pB + (size_t)1536 * 1024; vM = 512; }
                break;
            case OP_GEMM_QB:
                jp = true; pA = (const bf16_t*)(ws + OFF_EB) + 1024; pldA = 1536; pK = 256; pB = (const bf16_t*)(ws + OFF_QB) + li * SZ_QB; pN = 768; eP = EpiPlain{(bf16_t*)(ws + OFF_QD), 768, 0};
                break;
            case OP_GEMM_KVB:
                jp = jv = true; pA = (const bf16_t*)(ws + OFF_EB) + 1280; pldA = 1536; pK = 128; pB = (const bf16_t*)(ws + OFF_KVB) + li * SZ_KVB; pN = 512; eP = EpiPlain{(bf16_t*)(ws + OFF_KD), 768, 1};
                vA = pB + (size_t)512 * 128; vM = 512; vB = pA; vldB = 1536; vK = 128; vhead = 8;
                break;
            case OP_GEMM_OUT:
                jr = true; rA = (const bf16_t*)(ws + OFF_HM); rK = 1024; rB = (const bf16_t*)(ws + (even ? OFF_EVOUT : OFF_ODOUT)) + li * SZ_OUT; rxin = xin;
                break;
            case OP_GEMM_GU: jg = true; break;
            default:
                jr = true; rA = (const bf16_t*)(ws + OFF_ACT); rK = DFF; rB = (const bf16_t*)(ws + OFF_DN) + layer * SZ_DN; rxin = p.out;
                break;
            }
            if (jp) run_gemm(smem, pA, pldA, M_TOK, pB, pK, pN, pK, eP);
            if (jv) run_gemm(smem, vA, vK, vM, vB, vldB, M_TOK, vK, EpiVT{(bf16_t*)(ws + OFF_VT), vhead});
            if (jr) run_gemm(smem, rA, rK, M_TOK, rB, rK, 1024, rK, EpiResid{rxin, p.out});
            for (int rep = 0; rep < DBG_REP_GU; ++rep)
            if (jg) run_gemm(smem, (const bf16_t*)(ws + OFF_HM), 1024, M_TOK, (const bf16_t*)(ws + OFF_GU) + layer * SZ_GU, 1024, 5632, 1024, EpiSwiglu{(bf16_t*)(ws + OFF_ACT)});
            if (sync) gsync(bar, btarget);
            if (DBG_EXTRA_SYNC) gsync(bar, btarget);
        }
    }
#ifdef DBG_STEPS
    gsync(bar, btarget);
    {
        const size_t n = (size_t)M_TOK * 1024;
        const bf16_t* b0 = (const bf16_t*)(ws + OFF_HM);
        const bf16_t* b1 = (const bf16_t*)(ws + DBG_OFF1);
        const bf16_t* b2 = (const bf16_t*)(ws + DBG_OFF2);
        const bf16_t* b3 = (const bf16_t*)(ws + OFF_EB + (size_t)M_TOK * 1024 * 2);
        for (size_t i = (size_t)blockIdx.x * NT + threadIdx.x; i < n; i += (size_t)gridDim.x * NT) {
            float v = bf_lo(b0[i]) + bf_lo(b1[i]) + bf_lo(b2[i]) + bf_lo(b3[i]);
            if (DBG_STEPS >= 5) v += p.out[i];
            p.out[i] = v;
        }
    }
#endif
}

extern "C" void kernel_launch(void* const* d_in, const int* in_sizes, int n_in, void* d_out, int out_size, void* d_ws, size_t ws_size,
                              hipStream_t stream) {
    if (ws_size < OFF_END + 256) return;
    static int grid_blocks = 0;
    if (!grid_blocks) {
        int dev = 0, cus = 0, per_cu = 0;
        hipGetDevice(&dev);
        hipDeviceGetAttribute(&cus, hipDeviceAttributeMultiprocessorCount, dev);
        hipFuncSetAttribute((const void*)fwd_megakernel, hipFuncAttributeMaxDynamicSharedMemorySize, SMEM_BYTES);
        hipOccupancyMaxActiveBlocksPerMultiprocessor(&per_cu, fwd_megakernel, NT, SMEM_BYTES);
        if (per_cu > 1) per_cu = 1;
        if (per_cu < 1) per_cu = 1;
        grid_blocks = cus * per_cu;
    }
    Params p{};
    p.x = (const float*)d_in[0]; p.ffn_norm = (const float*)d_in[1]; p.w_gu = (const float*)d_in[2]; p.w_dn = (const float*)d_in[3];
    p.rel_bias = (const float*)d_in[4]; p.ev_norm = (const float*)d_in[5]; p.ev_w_in = (const float*)d_in[6]; p.ev_fb = (const float*)d_in[7];
    p.ev_qn = (const float*)d_in[8]; p.ev_kn = (const float*)d_in[9]; p.ev_w_out = (const float*)d_in[10]; p.od_norm = (const float*)d_in[11];
    p.od_w_in = (const float*)d_in[12]; p.od_mqn = (const float*)d_in[13]; p.od_mkn = (const float*)d_in[14]; p.od_qan = (const float*)d_in[15];
    p.od_wqb = (const float*)d_in[16]; p.od_kvan = (const float*)d_in[17]; p.od_wkvb = (const float*)d_in[18]; p.od_lqn = (const float*)d_in[19];
    p.od_lkn = (const float*)d_in[20]; p.od_w_out = (const float*)d_in[21];
    p.out = (float*)d_out; p.ws = (char*)d_ws;
    hipMemsetAsync((char*)d_ws + OFF_BAR, 0, 256, stream);
    void* args[] = {&p};
    hipError_t e = hipLaunchCooperativeKernel((void*)fwd_megakernel, dim3(grid_blocks), dim3(NT), args, SMEM_BYTES, stream);
    if (e != hipSuccess) fprintf(stderr, "cooperative launch failed: %s (grid %d)\n", hipGetErrorString(e), grid_blocks);
}
```
